# Optimizing an MI355X kernel written in HIP

```python
import math
import jax, jax.numpy as jnp
from jax import lax
import numpy as np

D_MODEL = 2048
BATCH = 4
SEQ = 4096
DEPTH = 2

D_MIX = D_MODEL
A_HEADS = 8
A_QK_DIM = 64
A_V_DIM = 2 * A_QK_DIM
A_WIDTH = A_HEADS * A_V_DIM
B_GROUPS = 4
B_CHUNK = 128
B_WIDTH = D_MIX // 4
B_GROUP_DIM = B_WIDTH // B_GROUPS
C_GROUPS = 4
C_WIDTH = D_MIX - A_WIDTH - B_WIDTH
CONV_K = 3

ROPE_THETA = 10000.0
Q_BLOCK = 128
NORM_EPS = 1e-5
LN_EPS = 1e-5

PROJ_SIZES = (A_HEADS * 2 * A_QK_DIM, A_HEADS * 2 * A_QK_DIM, A_WIDTH, A_WIDTH,
              B_WIDTH, B_WIDTH, B_WIDTH,
              C_WIDTH, C_WIDTH, C_WIDTH, C_WIDTH)
PROJ_COLS = sum(PROJ_SIZES)

kernel_name = "hybrid_diffattn_sgu_shortconv"


def _split_points():
    pts, acc = [], 0
    for s in PROJ_SIZES[:-1]:
        acc += s
        pts.append(acc)
    return pts


def rms_norm(x, w):
    xf = x.astype(jnp.float32)
    y = xf * lax.rsqrt(jnp.mean(xf * xf, axis=-1, keepdims=True) + NORM_EPS)
    return (y * w.astype(jnp.float32)).astype(x.dtype)


def layer_norm(x, g, b):
    xf = x.astype(jnp.float32)
    mu = jnp.mean(xf, axis=-1, keepdims=True)
    xc = xf - mu
    var = jnp.mean(xc * xc, axis=-1, keepdims=True)
    y = xc * lax.rsqrt(var + LN_EPS) * g.astype(jnp.float32) + b.astype(jnp.float32)
    return y.astype(x.dtype)


def rotary_tables(seq, dim, dtype):
    pos = jnp.arange(seq, dtype=jnp.float32)
    inv_freq = ROPE_THETA ** (-jnp.arange(0, dim, 2, dtype=jnp.float32) / dim)
    ang = pos[:, None] * inv_freq[None, :]
    return jnp.cos(ang).astype(dtype), jnp.sin(ang).astype(dtype)


def apply_rotary(x, cos, sin):
    x1, x2 = jnp.split(x, 2, axis=-1)
    c = cos[None, :, None, None, :]
    s = sin[None, :, None, None, :]
    return jnp.concatenate([x1 * c - x2 * s, x2 * c + x1 * s], axis=-1)


def diff_attention(q, k, v, lam, cos, sin):
    b, s, h, _, d = q.shape
    q = apply_rotary(q, cos, sin)
    k = apply_rotary(k, cos, sin)
    scale = d ** -0.5
    nb = s // Q_BLOCK
    q_blocks = q.reshape(b, nb, Q_BLOCK, h, 2, d).swapaxes(0, 1)
    k32 = k.astype(jnp.float32)
    key_pos = jnp.arange(s)
    neg = jnp.finfo(jnp.float32).min

    def one_block(args):
        q_blk, start = args
        sc = jnp.einsum('bqhcd,bkhcd->bhcqk', q_blk.astype(jnp.float32), k32) * scale
        q_pos = start + jnp.arange(Q_BLOCK)
        causal = key_pos[None, :] <= q_pos[:, None]
        sc = jnp.where(causal, sc, neg)
        p = jax.nn.softmax(sc, axis=-1)
        attn = p[:, :, 0] - lam * p[:, :, 1]
        return jnp.einsum('bhqk,bkhe->bqhe', attn.astype(v.dtype), v)

    out = lax.map(one_block, (q_blocks, jnp.arange(nb) * Q_BLOCK))
    return out.swapaxes(0, 1).reshape(b, s, h, v.shape[-1])


def spatial_gating(u, v, ln_g, ln_b, w_s, b_s):
    b, s, _ = v.shape
    v = layer_norm(v, ln_g, ln_b)
    nc = s // B_CHUNK
    vc = v.reshape(b, nc, B_CHUNK, B_GROUPS, B_GROUP_DIM)
    w = jnp.tril(w_s)
    mixed = jnp.einsum('gts,bcsgd->bctgd', w, vc) + b_s.T[None, None, :, :, None]
    return u * mixed.reshape(b, s, B_WIDTH)


def short_conv(xc, bgate, cgate, conv_w):
    z = cgate * xc
    s = z.shape[1]
    zp = jnp.pad(z, ((0, 0), (CONV_K - 1, 0), (0, 0)))
    y = conv_w[0] * zp[:, 0:s]
    for i in range(1, CONV_K):
        y = y + conv_w[i] * zp[:, i:i + s]
    return bgate * y


def hybrid_layer(x, layer_idx, norm_w, w_in, lam_q1, lam_k1, lam_q2, lam_k2, subln_w,
                 sgu_ln_g, sgu_ln_b, w_s, b_s, conv_w, w_out, cos, sin):
    b, s, _ = x.shape
    h = rms_norm(x, norm_w)
    proj = h @ w_in
    (q, k, v, gate_a, u, v_s, gate_b, xc, bgate, cgate, gate_c) = jnp.split(
        proj, _split_points(), axis=-1)

    lam_init = 0.8 - 0.6 * math.exp(-0.3 * layer_idx)
    lam = (jnp.exp(jnp.sum(lam_q1.astype(jnp.float32) * lam_k1.astype(jnp.float32)))
           - jnp.exp(jnp.sum(lam_q2.astype(jnp.float32) * lam_k2.astype(jnp.float32)))
           + lam_init)
    q = q.reshape(b, s, A_HEADS, 2, A_QK_DIM)
    k = k.reshape(b, s, A_HEADS, 2, A_QK_DIM)
    v = v.reshape(b, s, A_HEADS, A_V_DIM)
    ya = diff_attention(q, k, v, lam, cos, sin)
    ya = rms_norm(ya, subln_w) * (1.0 - lam_init)
    ya = ya.reshape(b, s, A_WIDTH) * jax.nn.silu(gate_a)

    yb = spatial_gating(u, v_s, sgu_ln_g, sgu_ln_b, w_s, b_s) * jax.nn.silu(gate_b)

    yc = short_conv(xc, bgate, cgate, conv_w) * jax.nn.silu(gate_c)

    y = jnp.concatenate([ya, yb, yc], axis=-1) @ w_out
    return x + y


def setup_inputs(seed: int = 0) -> dict:
    key = jax.random.key(seed)
    ks = jax.random.split(key, 16)
    f32 = jnp.float32
    nrm = lambda k, shape: jax.random.normal(k, shape, dtype=f32)
    return {
        "x": nrm(ks[0], (BATCH, SEQ, D_MODEL)),
        "norm_w": 1.0 + 0.02 * nrm(ks[1], (DEPTH, D_MODEL)),
        "w_in": nrm(ks[2], (DEPTH, D_MODEL, PROJ_COLS)) * D_MODEL ** -0.5,
        "lam_q1": 0.1 * nrm(ks[3], (DEPTH, A_QK_DIM)),
        "lam_k1": 0.1 * nrm(ks[4], (DEPTH, A_QK_DIM)),
        "lam_q2": 0.1 * nrm(ks[5], (DEPTH, A_QK_DIM)),
        "lam_k2": 0.1 * nrm(ks[6], (DEPTH, A_QK_DIM)),
        "subln_w": 1.0 + 0.02 * nrm(ks[7], (DEPTH, A_V_DIM)),
        "sgu_ln_g": 1.0 + 0.02 * nrm(ks[8], (DEPTH, B_WIDTH)),
        "sgu_ln_b": 0.02 * nrm(ks[9], (DEPTH, B_WIDTH)),
        "w_s": nrm(ks[10], (DEPTH, B_GROUPS, B_CHUNK, B_CHUNK)) * B_CHUNK ** -0.5,
        "b_s": 1.0 + 0.1 * nrm(ks[11], (DEPTH, B_GROUPS, B_CHUNK)),
        "conv_w": nrm(ks[12], (DEPTH, CONV_K, C_WIDTH)) * CONV_K ** -0.5,
        "w_out": nrm(ks[13], (DEPTH, D_MIX, D_MODEL)) * D_MIX ** -0.5,
        "final_norm_w": 1.0 + 0.02 * nrm(ks[14], (D_MODEL,)),
    }


def reference(x, norm_w, w_in, lam_q1, lam_k1, lam_q2, lam_k2, subln_w, sgu_ln_g, sgu_ln_b,
              w_s, b_s, conv_w, w_out, final_norm_w):
    cos, sin = rotary_tables(x.shape[1], A_QK_DIM, x.dtype)
    for l in range(DEPTH):
        x = hybrid_layer(x, l, norm_w[l], w_in[l], lam_q1[l], lam_k1[l], lam_q2[l], lam_k2[l],
                         subln_w[l], sgu_ln_g[l], sgu_ln_b[l], w_s[l], b_s[l], conv_w[l],
                         w_out[l], cos, sin)
    return rms_norm(x, final_norm_w)
```

```cpp
#include <hip/hip_runtime.h>
#include <cstdio>
#include <cstdint>
namespace pg8 {
#define PG8_LAS __attribute__((address_space(3)))
typedef unsigned short bf16_t;
typedef short bf16x8 __attribute__((ext_vector_type(8)));
typedef float f32x4 __attribute__((ext_vector_type(4)));
typedef unsigned u32x4 __attribute__((ext_vector_type(4)));
constexpr int BM = 256, BK = 64, HALF = 128, HTB = HALF * BK * 2  , STAGE_BYTES = 8 * HTB, NXCD = 8, WGM = 8;

__host__ __device__ __forceinline__ int lds_byte(int r, int c) { const int st = (r >> 4) * 2 + (c >> 5), rr = r & 15, cc = c & 31, ob = rr * 64 + cc * 2; return st * 1024 + (ob ^ (((ob >> 9) & 1) << 5)); }
__host__ __device__ __forceinline__ void stage_rc(int b, int& R, int& C) { const int st = b / 1024, sb = b % 1024, swz = sb ^ (((sb >> 9) & 1) << 5); R = (st >> 1) * 16 + swz / 64; C = (st & 1) * 32 + (swz % 64) / 2; }
__host__ __device__ __forceinline__ int perm32(int rho) { const int n = rho >> 4, i = rho & 15; return 8 * (i >> 2) + 4 * n + (i & 3); }

struct Unit { int pm, pn; };
struct Gemm { const bf16_t* A; const bf16_t* Bt; int M, N, K; };

struct StaticOrder {
    int nM, nN, nwg, G, c;
    __host__ __device__ void init(int M, int N, int G_, int c_) { nM = M / BM; nN = N / BM; nwg = nM * nN; G = G_; c = c_; }
    __host__ __device__ bool next(int i, Unit& u) const {
        const long L = (long)i * G + c; if (L >= nwg) return false;
        int wgid = (int)L; { const int q = nwg / NXCD, r = nwg % NXCD, xcd = wgid % NXCD, off = wgid / NXCD; wgid = (xcd < r ? xcd * (q + 1) : r * (q + 1) + (xcd - r) * q) + off; }
        const int nig = WGM * nN, gid = wgid / nig, fm = gid * WGM, gsz = (nM - fm) < WGM ? (nM - fm) : WGM;
        u.pm = fm + ((wgid % nig) % gsz); u.pn = (wgid % nig) / gsz; return true;
    }
    __device__ __forceinline__ void a_ready(const Unit&) const {}
    __device__ __forceinline__ void done(const Unit&) const {}
};

__device__ __forceinline__ unsigned cvt_pk_bf16(float lo, float hi) { unsigned r; asm volatile("v_cvt_pk_bf16_f32 %0, %1, %2" : "=v"(r) : "v"(lo), "v"(hi)); return r; }
typedef float f32x2 __attribute__((ext_vector_type(2)));
constexpr float QK_C2 = 0.125f * 1.4426950408889634f;
constexpr int PROJ_LD = 7680, DMODEL = 2048;
__device__ __forceinline__ float silu_f(float v) { return v * __builtin_amdgcn_rcpf(1.0f + __builtin_amdgcn_exp2f(-1.4426950408889634f * v)); }
struct EpiProj {
    static constexpr bool PERM = true, AFTER_DRAIN = false;
    bf16_t* O; const float* ssq; const float* rope;
    __device__ __forceinline__ void operator()(const f32x4 (&acc)[2][2][4][2], const Unit& u, int wr, int wc, int fr, int fq) const {
        const int row0 = u.pm * BM + wr * 64 + fr, col0 = u.pn * BM + wc * 32 + 8 * fq, pn = u.pn;
        const int mode = (pn < 8) ? 1 : (((pn >= 12 && pn < 16) || pn == 20 || pn == 21 || pn >= 28) ? 2 : 0);
        const float qs = (pn < 4) ? QK_C2 : 1.0f;
        const int g4 = 4 * (4 * (wc & 1) + fq);
#pragma unroll
        for (int ai = 0; ai < 2; ++ai)
#pragma unroll
            for (int m = 0; m < 4; ++m) {
                const int row = row0 + ai * HALF + m * 16;
                const float rs = __builtin_amdgcn_rsqf(ssq[row] * (1.0f / 2048.0f) + 1e-5f);
                bf16_t* rowp = O + (size_t)row * PROJ_LD + col0;
                if (mode == 1) {
                    const float* rp = rope + (size_t)(row & 4095) * 64 + g4;
                    const f32x4 c4 = *(const f32x4*)rp, s4 = *(const f32x4*)(rp + 32);
                    const float sc = rs * qs;
#pragma unroll
                    for (int bj = 0; bj < 2; ++bj) { const f32x4 v0 = acc[ai][bj][m][0] * sc, v1 = acc[ai][bj][m][1] * sc;
                        const f32x4 o0 = v0 * c4 - v1 * s4, o1 = v1 * c4 + v0 * s4;
                        u32x4 w; w.x = cvt_pk_bf16(o0[0], o0[1]); w.y = cvt_pk_bf16(o0[2], o0[3]); w.z = cvt_pk_bf16(o1[0], o1[1]); w.w = cvt_pk_bf16(o1[2], o1[3]);
                        *(u32x4*)(rowp + bj * HALF) = w; }
                } else if (mode == 2) {
#pragma unroll
                    for (int bj = 0; bj < 2; ++bj) { f32x4 v0 = acc[ai][bj][m][0] * rs, v1 = acc[ai][bj][m][1] * rs;
#pragma unroll
                        for (int j = 0; j < 4; ++j) { v0[j] = silu_f(v0[j]); v1[j] = silu_f(v1[j]); }
                        u32x4 w; w.x = cvt_pk_bf16(v0[0], v0[1]); w.y = cvt_pk_bf16(v0[2], v0[3]); w.z = cvt_pk_bf16(v1[0], v1[1]); w.w = cvt_pk_bf16(v1[2], v1[3]);
                        *(u32x4*)(rowp + bj * HALF) = w; }
                } else {
#pragma unroll
                    for (int bj = 0; bj < 2; ++bj) { const f32x4 v0 = acc[ai][bj][m][0] * rs, v1 = acc[ai][bj][m][1] * rs;
                        u32x4 w; w.x = cvt_pk_bf16(v0[0], v0[1]); w.y = cvt_pk_bf16(v0[2], v0[3]); w.z = cvt_pk_bf16(v1[0], v1[1]); w.w = cvt_pk_bf16(v1[2], v1[3]);
                        *(u32x4*)(rowp + bj * HALF) = w; }
                }
            }
    }
};
struct EpiResid {
    static constexpr bool PERM = true, AFTER_DRAIN = false;
    const float* base32; const bf16_t* base16; bf16_t* xb; float* ssq;
    __device__ __forceinline__ void operator()(const f32x4 (&acc)[2][2][4][2], const Unit& u, int wr, int wc, int fr, int fq) const {
        const int row0 = u.pm * BM + wr * 64 + fr, col0 = u.pn * BM + wc * 32 + 8 * fq;
#pragma unroll
        for (int ai = 0; ai < 2; ++ai)
#pragma unroll
            for (int m = 0; m < 4; ++m) {
                const int row = row0 + ai * HALF + m * 16; const size_t off = (size_t)row * DMODEL + col0;
                f32x4 b[2][2];
                if (base32) {
#pragma unroll
                    for (int bj = 0; bj < 2; ++bj) { b[bj][0] = *(const f32x4*)(base32 + off + bj * HALF); b[bj][1] = *(const f32x4*)(base32 + off + bj * HALF + 4); }
                } else {
#pragma unroll
                    for (int bj = 0; bj < 2; ++bj) { const u32x4 w = *(const u32x4*)(base16 + off + bj * HALF);
                        b[bj][0] = (f32x4){__uint_as_float(w.x << 16), __uint_as_float(w.x & 0xffff0000u), __uint_as_float(w.y << 16), __uint_as_float(w.y & 0xffff0000u)};
                        b[bj][1] = (f32x4){__uint_as_float(w.z << 16), __uint_as_float(w.z & 0xffff0000u), __uint_as_float(w.w << 16), __uint_as_float(w.w & 0xffff0000u)}; }
                }
                float part = 0.f;
#pragma unroll
                for (int bj = 0; bj < 2; ++bj) { const f32x4 x0 = b[bj][0] + acc[ai][bj][m][0], x1 = b[bj][1] + acc[ai][bj][m][1];
                    u32x4 w; w.x = cvt_pk_bf16(x0[0], x0[1]); w.y = cvt_pk_bf16(x0[2], x0[3]); w.z = cvt_pk_bf16(x1[0], x1[1]); w.w = cvt_pk_bf16(x1[2], x1[3]); *(u32x4*)(xb + off + bj * HALF) = w;
                    part += (x0[0] * x0[0] + x0[1] * x0[1]) + (x0[2] * x0[2] + x0[3] * x0[3]) + (x1[0] * x1[0] + x1[1] * x1[1]) + (x1[2] * x1[2] + x1[3] * x1[3]); }
                if (ssq) { part += __shfl_xor(part, 16); part += __shfl_xor(part, 32); if (fq == 0) atomicAdd(ssq + row, part); }
            }
    }
};


template <class Epi, class Sched, bool ALIGN_EPI = false, bool SP2 = false>
__device__ __forceinline__ void gemm_phase(PG8_LAS unsigned char* lds, const Gemm g, const Sched& S, const Epi& E) {
    int tid_ = threadIdx.x; asm volatile("" : "+v"(tid_));
    const int tid = tid_, wid = __builtin_amdgcn_readfirstlane(tid >> 6), lane = tid & 63, wr = wid >> 2, wc = wid & 3, fr = lane & 15, fq = lane >> 4;
    const int K = g.K, nt = K / BK;
    unsigned voffA[2], voffB[2];
#pragma unroll
    for (int i = 0; i < 2; ++i) { int R, C; stage_rc(tid * 16 + i * 8192, R, C); const int Rb = Epi::PERM ? ((R & ~31) + perm32(R & 31)) : R;
        voffA[i] = (unsigned)(R * K + C) * 2u; voffB[i] = (unsigned)(Rb * K + C) * 2u; }
    const size_t kstep = (size_t)(BK * 2);
    const size_t hstep = (size_t)HALF * K * 2;
    const size_t tstep = 2 * hstep;
    const unsigned ldsw = (unsigned)wid * 1024u;
    const int aoff = lds_byte(wr * 64 + fr, fq * 8), boff = lds_byte(wc * 32 + fr, fq * 8);
#define PG8_SA(b, h) (((b) * 2 + (h)) * HTB)
#define PG8_SB(b, h) ((4 + (b) * 2 + (h)) * HTB)
#define PG8_STAGE(bufoff, gbase, voff) do { _Pragma("unroll") for (int _i = 0; _i < 2; ++_i) \
        __builtin_amdgcn_global_load_lds((const unsigned*)((const char*)(gbase) + (voff)[_i]), (PG8_LAS unsigned*)(lds + (bufoff) + ldsw + _i * 8192), 16, 0, 0); } while (0)
#define PG8_LDA(dst, b, h) do { _Pragma("unroll") for (int m = 0; m < 4; ++m) _Pragma("unroll") for (int k = 0; k < 2; ++k) dst[m][k] = *(const PG8_LAS bf16x8*)(lds + PG8_SA(b, h) + aoff + m * 2048 + k * 1024); } while (0)
#define PG8_LDB(dst, b, h) do { _Pragma("unroll") for (int n = 0; n < 2; ++n) _Pragma("unroll") for (int k = 0; k < 2; ++k) dst[n][k] = *(const PG8_LAS bf16x8*)(lds + PG8_SB(b, h) + boff + n * 2048 + k * 1024); } while (0)
#define PG8_MMA(ai, bj, At, Bt) do { __builtin_amdgcn_s_setprio(1); _Pragma("unroll") for (int m = 0; m < 4; ++m) _Pragma("unroll") for (int n = 0; n < 2; ++n) _Pragma("unroll") for (int k = 0; k < 2; ++k) \
        acc[ai][bj][m][n] = __builtin_amdgcn_mfma_f32_16x16x32_bf16(Bt[n][k], At[m][k], acc[ai][bj][m][n], 0, 0, 0); __builtin_amdgcn_s_setprio(0); } while (0)
#define PG8_WAIT_V(n) asm volatile("s_waitcnt vmcnt(" #n ")" ::: "memory")
#define PG8_WAIT_L(n) asm volatile("s_waitcnt lgkmcnt(" #n ")" ::: "memory")
#define PG8_BAR __builtin_amdgcn_s_barrier()
#define PG8_SCHED __builtin_amdgcn_sched_barrier(0)
    Unit cur, nxt; int ui = 0;
    if (!S.next(0, cur)) return;
    f32x4 acc[2][2][4][2];
#pragma unroll
    for (int a = 0; a < 2; ++a)
#pragma unroll
        for (int b = 0; b < 2; ++b)
#pragma unroll
            for (int m = 0; m < 4; ++m)
#pragma unroll
                for (int n = 0; n < 2; ++n) acc[a][b][m][n] = (f32x4){0.f, 0.f, 0.f, 0.f};
    bf16x8 At[4][2], B0[2][2], B1[2][2];
    const char* cA = (const char*)g.A + (size_t)cur.pm * tstep; const char* cB = (const char*)g.Bt + (size_t)cur.pn * tstep;
    S.a_ready(cur);
    if constexpr (SP2) {
        PG8_STAGE(PG8_SB(0, 0), cB, voffB); PG8_STAGE(PG8_SB(0, 1), cB + hstep, voffB); PG8_STAGE(PG8_SA(0, 0), cA, voffA); PG8_STAGE(PG8_SA(0, 1), cA + hstep, voffA);
        if (wr == 1) PG8_BAR;
        PG8_WAIT_V(2); PG8_BAR;
        PG8_STAGE(PG8_SB(1, 0), cB + kstep, voffB); PG8_STAGE(PG8_SA(1, 0), cA + kstep, voffA); PG8_STAGE(PG8_SB(1, 1), cB + hstep + kstep, voffB);
        PG8_WAIT_V(6); PG8_BAR;
    } else {
        PG8_STAGE(PG8_SB(0, 0), cB, voffB); PG8_STAGE(PG8_SA(0, 0), cA, voffA); PG8_STAGE(PG8_SB(0, 1), cB + hstep, voffB); PG8_STAGE(PG8_SA(0, 1), cA + hstep, voffA);
        if (wr == 1) PG8_BAR;
        PG8_WAIT_V(4); PG8_BAR;
        PG8_STAGE(PG8_SB(1, 0), cB + kstep, voffB); PG8_STAGE(PG8_SA(1, 0), cA + kstep, voffA); PG8_STAGE(PG8_SB(1, 1), cB + hstep + kstep, voffB);
        PG8_WAIT_V(6); PG8_BAR;
    }
    for (;;) {
        const bool has_next = S.next(ui + 1, nxt);
        const char* nA = has_next ? (const char*)g.A + (size_t)nxt.pm * tstep : cA; const char* nB = has_next ? (const char*)g.Bt + (size_t)nxt.pn * tstep : cB;
        for (int t = 0; t < nt; t += 2) {
            const bool last = (t == nt - 2);
            const char* a1 = cA + (size_t)(t + 1) * kstep;
            const char* a2 = last ? nA : cA + (size_t)(t + 2) * kstep; const char* b2 = last ? nB : cB + (size_t)(t + 2) * kstep;
            const char* a3 = a2 + kstep; const char* b3 = b2 + kstep;
            if (last && has_next) S.a_ready(nxt);
            if constexpr (SP2) {
            PG8_LDB(B0, 0, 0); PG8_LDB(B1, 0, 1); PG8_SCHED; PG8_LDA(At, 0, 0); PG8_STAGE(PG8_SA(1, 1), a1 + hstep, voffA);
            PG8_WAIT_V(8); PG8_WAIT_L(0); PG8_BAR; PG8_MMA(0, 0, At, B0); PG8_MMA(0, 1, At, B1); PG8_BAR; PG8_SCHED;
            PG8_LDA(At, 0, 1); PG8_STAGE(PG8_SB(0, 0), b2, voffB); PG8_STAGE(PG8_SB(0, 1), b2 + hstep, voffB); PG8_STAGE(PG8_SA(0, 0), a2, voffA);
            PG8_WAIT_V(8); PG8_WAIT_L(0); PG8_BAR; PG8_MMA(1, 0, At, B0); PG8_MMA(1, 1, At, B1); PG8_BAR; PG8_SCHED;
            PG8_LDB(B0, 1, 0); PG8_LDB(B1, 1, 1); PG8_SCHED; PG8_LDA(At, 1, 0); PG8_STAGE(PG8_SA(0, 1), a2 + hstep, voffA);
            PG8_WAIT_V(8); PG8_WAIT_L(0); PG8_BAR; PG8_MMA(0, 0, At, B0); PG8_MMA(0, 1, At, B1); PG8_BAR; PG8_SCHED;
            PG8_LDA(At, 1, 1); PG8_STAGE(PG8_SB(1, 0), b3, voffB); PG8_STAGE(PG8_SB(1, 1), b3 + hstep, voffB); PG8_STAGE(PG8_SA(1, 0), a3, voffA);
            PG8_WAIT_V(8); PG8_WAIT_L(0); PG8_BAR; PG8_MMA(1, 0, At, B0); PG8_MMA(1, 1, At, B1); PG8_BAR; PG8_SCHED;
            } else {
            PG8_LDB(B0, 0, 0); PG8_SCHED; PG8_LDA(At, 0, 0); PG8_STAGE(PG8_SA(1, 1), a1 + hstep, voffA);
            PG8_WAIT_L(8); PG8_BAR; PG8_WAIT_L(0); PG8_MMA(0, 0, At, B0); PG8_BAR; PG8_SCHED;
            PG8_LDB(B1, 0, 1); PG8_STAGE(PG8_SB(0, 0), b2, voffB);
            PG8_BAR; PG8_WAIT_L(0); PG8_MMA(0, 1, At, B1); PG8_BAR;
            PG8_LDA(At, 0, 1); PG8_STAGE(PG8_SA(0, 0), a2, voffA);
            PG8_BAR; PG8_WAIT_L(0); PG8_MMA(1, 0, At, B0); PG8_BAR; PG8_SCHED;
            PG8_STAGE(PG8_SB(0, 1), b2 + hstep, voffB);
            PG8_WAIT_V(6); PG8_BAR; PG8_MMA(1, 1, At, B1); PG8_BAR;
            PG8_LDB(B0, 1, 0); PG8_SCHED; PG8_LDA(At, 1, 0); PG8_STAGE(PG8_SA(0, 1), a2 + hstep, voffA);
            PG8_WAIT_L(8); PG8_BAR; PG8_WAIT_L(0); PG8_MMA(0, 0, At, B0); PG8_BAR; PG8_SCHED;
            PG8_LDB(B1, 1, 1); PG8_STAGE(PG8_SB(1, 0), b3, voffB);
            PG8_BAR; PG8_WAIT_L(0); PG8_MMA(0, 1, At, B1); PG8_BAR;
            PG8_LDA(At, 1, 1); PG8_STAGE(PG8_SA(1, 0), a3, voffA);
            PG8_BAR; PG8_WAIT_L(0); PG8_MMA(1, 0, At, B0); PG8_BAR; PG8_SCHED;
            PG8_STAGE(PG8_SB(1, 1), b3 + hstep, voffB);
            PG8_WAIT_V(6); PG8_BAR; PG8_MMA(1, 1, At, B1); PG8_BAR;
            }
        }
        if constexpr (ALIGN_EPI) { if (wr == 0) PG8_BAR; }
        if constexpr (!Epi::AFTER_DRAIN) { E(acc, cur, wr, wc, fr, fq); S.done(cur); }
        if (!has_next) break;
#pragma unroll
        for (int a = 0; a < 2; ++a)
#pragma unroll
            for (int b = 0; b < 2; ++b)
#pragma unroll
                for (int m = 0; m < 4; ++m)
#pragma unroll
                    for (int n = 0; n < 2; ++n) acc[a][b][m][n] = (f32x4){0.f, 0.f, 0.f, 0.f};
        cur = nxt; cA = nA; cB = nB; ++ui;
        if constexpr (ALIGN_EPI) { if (wr == 1) PG8_BAR; }
    }
    PG8_WAIT_V(0);
    if constexpr (!ALIGN_EPI) { if (wr == 0) PG8_BAR; }
    PG8_BAR;
    if constexpr (Epi::AFTER_DRAIN) { E.fused(acc, cur, wr, wc, fr, fq, lds, wid, lane); S.done(cur); }
#undef PG8_SA
#undef PG8_SB
#undef PG8_STAGE
#undef PG8_LDA
#undef PG8_LDB
#undef PG8_MMA
#undef PG8_WAIT_V
#undef PG8_WAIT_L
#undef PG8_BAR
#undef PG8_SCHED
}
}
#ifndef PG8_SP2
#define PG8_SP2 true
#endif
#ifndef PG8_ALIGN
#define PG8_ALIGN true
#endif
#include <hip/hip_bf16.h>
#include <cmath>
namespace attn_body {
using bf16=__hip_bfloat16;
using bf16x8=__attribute__((ext_vector_type(8)))short;
using s16x4=__attribute__((ext_vector_type(4)))short;
using f32x16=__attribute__((ext_vector_type(16)))float;
using u32x4=__attribute__((ext_vector_type(4)))unsigned;
constexpr int BATCH=4,NHEAD=8,SEQ=4096,D=64,PQ=7680,PO=2048;
constexpr int NW=8,QBLK=32,QB=QBLK*NW,KVBLK=64,NQB=SEQ/QB;
constexpr int ATTN_UNIT_ROWS=QB;
__device__ __forceinline__ int crow(int r,int hi){return (r&3)+8*(r>>2)+4*hi;}
#define SBAR() __builtin_amdgcn_sched_barrier(0)
__device__ __forceinline__ void cmask(f32x16&p0,f32x16&p1,int jb,int qrel,int hi){
  const float NEG=-INFINITY; int kb=64*jb+4*hi;
  #pragma unroll
  for(int r=0;r<16;++r){int kv=kb+(r&3)+8*(r>>2); if(kv>qrel)p0[r]=NEG; if(kv+32>qrel)p1[r]=NEG;}
}

constexpr int NSLOT=3, SLOTB=8192;
constexpr int LDS_K=0, LDS_V=NSLOT*SLOTB, LDS_WS=2*NSLOT*SLOTB, LDS_OST=LDS_WS+NW*64*4, LDS_BYTES=LDS_OST+NW*4096;
constexpr float C2=0.125f*1.4426950408889634f;
__device__ __forceinline__ void glds16(const void*gsrc,unsigned lds_dst){unsigned keep;
  asm volatile("s_mov_b32 %0, m0\n\ts_mov_b32 m0, %2\n\ts_nop 0\n\tglobal_load_lds_dwordx4 %1, off\n\ts_mov_b32 m0, %0":"=&s"(keep):"v"(gsrc),"s"(lds_dst):"memory");}
__device__ __forceinline__ float max3f(float a,float b,float c){float r;asm("v_max3_f32 %0, %1, %2, %3":"=v"(r):"v"(a),"v"(b),"v"(c));return r;}
__device__ __forceinline__ float max2f(float a,float b){float r;asm("v_max_f32_e32 %0, %1, %2":"=v"(r):"v"(a),"v"(b));return r;}
__device__ __forceinline__ float fadd_s(float a,float b){float r;asm("v_add_f32_e32 %0, %1, %2":"=v"(r):"v"(a),"v"(b));return r;}
__device__ __forceinline__ float fsub_s(float a,float b){float r;asm("v_sub_f32_e32 %0, %1, %2":"=v"(r):"v"(a),"v"(b));return r;}
typedef float f32x2_t __attribute__((ext_vector_type(2))); typedef __bf16 bf16x2_t __attribute__((ext_vector_type(2)));
__device__ __forceinline__ unsigned cvtpk_s(float lo,float hi){f32x2_t v={lo,hi};bf16x2_t b=__builtin_convertvector(v,bf16x2_t);return __builtin_bit_cast(unsigned,b);}
#define WAIT_BAR(N) asm volatile("s_waitcnt vmcnt(" #N ") lgkmcnt(0)\n\ts_barrier":::"memory")

__device__ __forceinline__ void qkt(f32x16&p0,f32x16&p1,const char*Kslot,const bf16x8*qr,const f32x16&negm,int r32,int hi){
  const char*kb=Kslot+hi*1024+r32*16;
  #pragma unroll
  for(int d0=0;d0<4;++d0){
    const bf16x8 b0=*reinterpret_cast<const bf16x8*>(kb+d0*2048);
    const bf16x8 b1=*reinterpret_cast<const bf16x8*>(kb+d0*2048+512);
    if(d0==0){p0=__builtin_amdgcn_mfma_f32_32x32x16_bf16(b0,qr[0],negm,0,0,0);p1=__builtin_amdgcn_mfma_f32_32x32x16_bf16(b1,qr[0],negm,0,0,0);}
    else{p0=__builtin_amdgcn_mfma_f32_32x32x16_bf16(b0,qr[d0],p0,0,0,0);p1=__builtin_amdgcn_mfma_f32_32x32x16_bf16(b1,qr[d0],p1,0,0,0);}}
}
typedef __attribute__((address_space(3))) const char* lds_cptr;
typedef short v4i16_t __attribute__((ext_vector_type(4)));
__device__ __forceinline__ void kload8(bf16x8*kf,lds_cptr kp){
  kf[0]=*(const __attribute__((address_space(3))) bf16x8*)(kp);      kf[1]=*(const __attribute__((address_space(3))) bf16x8*)(kp+512);
  kf[2]=*(const __attribute__((address_space(3))) bf16x8*)(kp+2048); kf[3]=*(const __attribute__((address_space(3))) bf16x8*)(kp+2560);
  kf[4]=*(const __attribute__((address_space(3))) bf16x8*)(kp+4096); kf[5]=*(const __attribute__((address_space(3))) bf16x8*)(kp+4608);
  kf[6]=*(const __attribute__((address_space(3))) bf16x8*)(kp+6144); kf[7]=*(const __attribute__((address_space(3))) bf16x8*)(kp+6656);
}
__device__ __forceinline__ void kload2(bf16x8*kf,lds_cptr kp,int j){ kf[2*j]=*(const __attribute__((address_space(3))) bf16x8*)(kp+j*2048); kf[2*j+1]=*(const __attribute__((address_space(3))) bf16x8*)(kp+j*2048+512); }
__device__ __forceinline__ s16x4 vtr(lds_cptr p){ return __builtin_bit_cast(s16x4,__builtin_amdgcn_ds_read_tr16_b64_v4i16((__attribute__((address_space(3))) v4i16_t*)p)); }
__device__ __forceinline__ float rowmax(const f32x16&p0,const f32x16&p1){
  float a=max3f(p0[0],p0[1],p1[0]),b=max3f(p0[2],p0[3],p1[1]);a=max3f(a,p1[2],p1[3]);
  #pragma unroll
  for(int r=4;r<16;r+=4){a=max3f(a,p0[r],p0[r+1]);b=max3f(b,p0[r+2],p0[r+3]);a=max3f(a,p1[r],p1[r+1]);b=max3f(b,p1[r+2],p1[r+3]);}
  const float m=max2f(a,b);
  auto rr=__builtin_amdgcn_permlane32_swap(__float_as_uint(m),__float_as_uint(m),false,false);
  return max2f(__uint_as_float(rr[0]),__uint_as_float(rr[1]));
}
__device__ __forceinline__ void pv(f32x16*o,int vb,bf16x8 pa0,bf16x8 pa1,bf16x8 pa2,bf16x8 pa3){
  #pragma unroll
  for(int d0=0;d0<2;++d0){s16x4 lo[4],hi[4];
    #pragma unroll
    for(int ks=0;ks<4;++ks){
      asm volatile("ds_read_b64_tr_b16 %0,%1 offset:%c2":"=&v"(lo[ks]):"v"(vb),"i"(d0*4096+ks*1024):"memory");
      asm volatile("ds_read_b64_tr_b16 %0,%1 offset:%c2":"=&v"(hi[ks]):"v"(vb),"i"(d0*4096+ks*1024+512):"memory");}
    asm volatile("s_waitcnt lgkmcnt(0)":::"memory");SBAR();
    #define PK(k) (bf16x8){lo[k][0],lo[k][1],lo[k][2],lo[k][3],hi[k][0],hi[k][1],hi[k][2],hi[k][3]}
    o[d0]=__builtin_amdgcn_mfma_f32_32x32x16_bf16(pa0,PK(0),o[d0],0,0,0);
    o[d0]=__builtin_amdgcn_mfma_f32_32x32x16_bf16(pa1,PK(1),o[d0],0,0,0);
    o[d0]=__builtin_amdgcn_mfma_f32_32x32x16_bf16(pa2,PK(2),o[d0],0,0,0);
    o[d0]=__builtin_amdgcn_mfma_f32_32x32x16_bf16(pa3,PK(3),o[d0],0,0,0);
    #undef PK
  }
}

#ifndef ATTN_STORE16
#define ATTN_STORE16(p,v) (*(u32x4*)(p)=(v))
#endif
template<int THRL> __device__ __forceinline__ void attn_unit(int b,int h,int qb,const bf16*Q,const bf16*__restrict__ K,const bf16*__restrict__ V,bf16*O,char*shm){
  int tid_=threadIdx.x; asm volatile("":"+v"(tid_)); const int tid=tid_,lane=tid&63,r32=lane&31,hi=lane>>5; const int wid=__builtin_amdgcn_readfirstlane(tid>>6);
  const long rowbase=(long)b*SEQ; const int q0=qb*QB;
  const bf16*Qw=Q+(rowbase+q0+wid*QBLK)*PQ;
  const bf16*Kh=K+rowbase*PQ,*Vh=V+rowbase*PQ;
  const unsigned lds0=(unsigned)(uintptr_t)shm;
  float*wsf=(float*)(shm+LDS_WS)+wid*64;
  const bf16*ksrc=Kh+(long)lane*PQ+wid*8;
  const bf16*vsrc=Vh+(long)(16*(wid&3)+(lane>>2))*PQ+(wid>>2)*32+(lane&3)*8;
  const unsigned kdst=lds0+LDS_K+wid*1024, vdst=lds0+LDS_V+wid*1024;
  #define DMA_K(t,slot) glds16(ksrc+(long)(t)*KVBLK*PQ,(unsigned)__builtin_amdgcn_readfirstlane(kdst+(slot)))
  #define DMA_V(t,slot) glds16(vsrc+(long)(t)*KVBLK*PQ,(unsigned)__builtin_amdgcn_readfirstlane(vdst+(slot)))
  const int vb0=(int)(lds0+LDS_V)+((lane>>4)&1)*32+(lane&3)*8+(4*hi+((lane&15)>>2))*64;
  const char*Kbase=shm+LDS_K; bf16x8 kf[8];
  const lds_cptr shm3=(lds_cptr)shm; const lds_cptr kp0=shm3+LDS_K+hi*1024+r32*16; const lds_cptr vp0=shm3+LDS_V+((lane>>4)&1)*32+(lane&3)*8+(4*hi+((lane&15)>>2))*64;
  const int NT=(q0+QB)/KVBLK;
  DMA_K(0,0);DMA_V(0,0);DMA_K(1,SLOTB);
  bf16x8 qr[4];
  #pragma unroll
  for(int d0=0;d0<4;++d0)qr[d0]=*reinterpret_cast<const bf16x8*>(&Qw[(long)r32*PQ+d0*16+hi*8]);
  float mhat=0.f,l_reg=0.f;f32x16 o[2];o[0]=f32x16{};o[1]=f32x16{};f32x16 negm=f32x16{};asm volatile("":"+v"(negm));
  const int qrel=wid*QBLK+r32;
  #define CMASK(P0,P1,t) do{int jb_=(t)-(NT-4); if(jb_>=0)cmask(P0,P1,jb_,qrel,hi);}while(0)
  bool resc=false;
  #define START(P0,P1) do{ const float rm=rowmax(P0,P1); resc=false; \
    { const float dl=rm; mhat=fadd_s(mhat,dl); \
      _Pragma("unroll") for(int r=0;r<16;++r){P0[r]=fsub_s(P0[r],dl);P1[r]=fsub_s(P1[r],dl);} \
      _Pragma("unroll") for(int r=0;r<16;++r)negm[r]=-mhat; asm volatile("":"+v"(negm)); } \
    _Pragma("unroll") for(int r=0;r<16;++r)P0[r]=__builtin_amdgcn_exp2f(P0[r]); }while(0)
  #define RESC() do{ if(resc){ asm volatile("s_waitcnt lgkmcnt(0)":::"memory"); \
      _Pragma("unroll") for(int d_=0;d_<2;++d_) _Pragma("unroll") for(int r=0;r<16;++r)o[d_][r]*=wsf[crow(r,hi)]; } }while(0)
  f32x16 pA0,pA1,pB0,pB1;
  int sl_prev=0,sl_cur=0,sl_next=SLOTB;
  #define ROT() do{sl_prev=sl_cur;sl_cur=sl_next;sl_next=(sl_next==(NSLOT-1)*SLOTB)?0:sl_next+SLOTB;}while(0)
  DMA_K(2,2*SLOTB);
  WAIT_BAR(3);
  qkt(pA0,pA1,Kbase,qr,negm,r32,hi);asm volatile("s_nop 15\n\ts_nop 7":"+v"(pA0),"+v"(pA1));CMASK(pA0,pA1,0);
  START(pA0,pA1);
  _Pragma("unroll") for(int r=0;r<16;++r)pA1[r]=__builtin_amdgcn_exp2f(pA1[r]);
  WAIT_BAR(0);
  DMA_K(3,0);DMA_V(1,SLOTB);
  ROT();
  kload8(kf,kp0+sl_cur);
  WAIT_BAR(2);
  s16x4 vlo[8],vhi[8]; u32x4 pw0,pw1,pw2,pw3;
  #define PKW(P,B) cvtpk_s(P[B],P[B+1])
  #define PAF(k) __builtin_bit_cast(bf16x8,pw##k)
  #define VFR(i) (bf16x8){vlo[i][0],vlo[i][1],vlo[i][2],vlo[i][3],vhi[i][0],vhi[i][1],vhi[i][2],vhi[i][3]}
  #define PIN(x) asm volatile("":"+v"(x))
  #define MX3(a,b,c) __builtin_fmaxf(__builtin_fmaxf((a),(b)),(c))
  #define GAPA(MF,A0,A1,A2,A3,W0,W1,PW) do{ MF; sacc+=A0; sacc+=A1; sacc+=A2; sacc+=A3; PIN(sacc); W0; W1; PIN(PW); SBAR(); }while(0)
  #define EX(v) __builtin_amdgcn_exp2f(v)
  #define GAPB(MF,X,B) do{ MF; X[B]=EX(X[B]); X[B+1]=EX(X[B+1]); X[B+2]=EX(X[B+2]); X[B+3]=EX(X[B+3]); PIN(X); SBAR(); }while(0)
  #define VRD(i) do{ vlo[i]=vtr(vp_+(((i)>>2)*4096+((i)&3)*1024)); vhi[i]=vtr(vp_+(((i)>>2)*4096+((i)&3)*1024+512)); }while(0)
  #define KRD(G,j) do{ if(G){ kload2(kf,kp0+sl_next,j); SBAR(); } }while(0)
  #define STEP(C0,C1,P0,P1,t,GK,GV,GL) do{ SBAR(); \
    const lds_cptr vp_=vp0+sl_prev; \
    VRD(0); SBAR(); float sacc=(P0[0]+P0[1]); \
    GAPA(C0=__builtin_amdgcn_mfma_f32_32x32x16_bf16(kf[0],qr[0],negm,0,0,0), P0[2],P0[3],P0[4],P0[5],     pw0[0]=PKW(P0,0), pw0[1]=PKW(P0,2), pw0); \
    VRD(4); SBAR(); GAPA(C1=__builtin_amdgcn_mfma_f32_32x32x16_bf16(kf[1],qr[0],negm,0,0,0), P0[6],P0[7],P0[8],P0[9],     pw0[2]=PKW(P0,4), pw0[3]=PKW(P0,6), pw0); \
    VRD(1); SBAR(); GAPA(C0=__builtin_amdgcn_mfma_f32_32x32x16_bf16(kf[2],qr[1],C0,0,0,0),   P0[10],P0[11],P0[12],P0[13], pw1[0]=PKW(P0,8), pw1[1]=PKW(P0,10), pw1); \
    VRD(5); SBAR(); GAPA(C1=__builtin_amdgcn_mfma_f32_32x32x16_bf16(kf[3],qr[1],C1,0,0,0),   P0[14],P0[15],P1[0],P1[1],   pw1[2]=PKW(P0,12),pw1[3]=PKW(P0,14), pw1); \
    VRD(2); SBAR(); GAPA(C0=__builtin_amdgcn_mfma_f32_32x32x16_bf16(kf[4],qr[2],C0,0,0,0),   P1[2],P1[3],P1[4],P1[5],     pw2[0]=PKW(P1,0), pw2[1]=PKW(P1,2), pw2); \
    VRD(6); SBAR(); GAPA(C1=__builtin_amdgcn_mfma_f32_32x32x16_bf16(kf[5],qr[2],C1,0,0,0),   P1[6],P1[7],P1[8],P1[9],     pw2[2]=PKW(P1,4), pw2[3]=PKW(P1,6), pw2); \
    VRD(3); SBAR(); GAPA(C0=__builtin_amdgcn_mfma_f32_32x32x16_bf16(kf[6],qr[3],C0,0,0,0),   P1[10],P1[11],P1[12],P1[13], pw3[0]=PKW(P1,8), pw3[1]=PKW(P1,10), pw3); \
    VRD(7); SBAR(); GAPA(C1=__builtin_amdgcn_mfma_f32_32x32x16_bf16(kf[7],qr[3],C1,0,0,0),   P1[14],P1[15],0.f,0.f,       pw3[2]=PKW(P1,12),pw3[3]=PKW(P1,14), pw3); \
    l_reg+=sacc; \
    if(GK){DMA_K((t)+3,sl_cur);} if(GV){DMA_V((t)+1,sl_next);} \
    CMASK(C0,C1,t); \
    { float a=MX3(C0[0],C0[1],C1[0]),b=MX3(C0[2],C0[3],C1[1]); a=MX3(a,C1[2],C1[3]); \
      _Pragma("unroll") for(int r=4;r<16;r+=4){a=MX3(a,C0[r],C0[r+1]);b=MX3(b,C0[r+2],C0[r+3]);a=MX3(a,C1[r],C1[r+1]);b=MX3(b,C1[r+2],C1[r+3]);} \
      float rm=__builtin_fmaxf(a,b); { auto rr=__builtin_amdgcn_permlane32_swap(__float_as_uint(rm),__float_as_uint(rm),false,false); rm=__builtin_fmaxf(__uint_as_float(rr[0]),__uint_as_float(rr[1])); } \
      resc=false; \
      if(__builtin_expect(__any(rm>(float)THRL),0)){ const float dl=__builtin_fmaxf(rm,0.f); mhat+=dl; \
        _Pragma("unroll") for(int r=0;r<16;++r){C0[r]-=dl;C1[r]-=dl;} \
        _Pragma("unroll") for(int r=0;r<16;++r)negm[r]=-mhat; asm volatile("":"+v"(negm)); \
        const float f=__builtin_amdgcn_exp2f(-dl); l_reg*=f; if(hi==0)wsf[r32]=f; resc=true; } } \
    SBAR(); \
    GAPB(o[0]=__builtin_amdgcn_mfma_f32_32x32x16_bf16(PAF(0),VFR(0),o[0],0,0,0), C0,0); \
    GAPB(o[1]=__builtin_amdgcn_mfma_f32_32x32x16_bf16(PAF(0),VFR(4),o[1],0,0,0), C0,4); \
    KRD(GL,0); GAPB(o[0]=__builtin_amdgcn_mfma_f32_32x32x16_bf16(PAF(1),VFR(1),o[0],0,0,0), C0,8); \
    KRD(GL,1); GAPB(o[1]=__builtin_amdgcn_mfma_f32_32x32x16_bf16(PAF(1),VFR(5),o[1],0,0,0), C0,12); \
    KRD(GL,2); GAPB(o[0]=__builtin_amdgcn_mfma_f32_32x32x16_bf16(PAF(2),VFR(2),o[0],0,0,0), C1,0); \
    KRD(GL,3); GAPB(o[1]=__builtin_amdgcn_mfma_f32_32x32x16_bf16(PAF(2),VFR(6),o[1],0,0,0), C1,4); \
    GAPB(o[0]=__builtin_amdgcn_mfma_f32_32x32x16_bf16(PAF(3),VFR(3),o[0],0,0,0), C1,8); \
    GAPB(o[1]=__builtin_amdgcn_mfma_f32_32x32x16_bf16(PAF(3),VFR(7),o[1],0,0,0), C1,12); \
    }while(0)
  int t=1;
  #undef CMASK
  #define CMASK(P0,P1,t) do{}while(0)
  for(;t+5<NT;t+=2){
    STEP(pB0,pB1,pA0,pA1,t,true,true,true);     WAIT_BAR(2); RESC(); ROT();
    STEP(pA0,pA1,pB0,pB1,t+1,true,true,true);   WAIT_BAR(2); RESC(); ROT();
  }
  #undef CMASK
  #define CMASK(P0,P1,t) do{int jb_=(t)-(NT-4); if(jb_>=0)cmask(P0,P1,jb_,qrel,hi);}while(0)
  #define ENDW(tt) do{ if((tt)+3<NT){WAIT_BAR(2);} else if((tt)+2<NT){WAIT_BAR(1);} else {WAIT_BAR(0);} }while(0)
  for(;t+1<NT;t+=2){
    STEP(pB0,pB1,pA0,pA1,t,(t+3<NT),(t+1<NT),(t+1<NT));       ENDW(t);   RESC(); ROT();
    STEP(pA0,pA1,pB0,pB1,t+1,(t+4<NT),(t+2<NT),(t+2<NT));     ENDW(t+1); RESC(); ROT();
  }
  STEP(pB0,pB1,pA0,pA1,NT-1,false,false,false); RESC();
  { float sacc=pB0[0]+pB0[1]; _Pragma("unroll") for(int r=2;r<16;++r)sacc+=pB0[r]; _Pragma("unroll") for(int r=0;r<16;++r)sacc+=pB1[r]; l_reg+=sacc;
    pw0=(u32x4){PKW(pB0,0),PKW(pB0,2),PKW(pB0,4),PKW(pB0,6)};pw1=(u32x4){PKW(pB0,8),PKW(pB0,10),PKW(pB0,12),PKW(pB0,14)};pw2=(u32x4){PKW(pB1,0),PKW(pB1,2),PKW(pB1,4),PKW(pB1,6)};pw3=(u32x4){PKW(pB1,8),PKW(pB1,10),PKW(pB1,12),PKW(pB1,14)};
    SBAR(); pv(o,vb0+sl_cur,PAF(0),PAF(1),PAF(2),PAF(3)); }
  #undef PKW
  #undef PAF
  #undef VFR
  #undef PIN
  #undef MX3
  #undef GAPA
  #undef GAPB
  #undef EX
  #undef VRD
  #undef KRD
  #undef STEP
  #undef ENDW
  {auto rr=__builtin_amdgcn_permlane32_swap(__float_as_uint(l_reg),__float_as_uint(l_reg),false,false);l_reg=__uint_as_float(rr[0])+__uint_as_float(rr[1]);}
  if(hi==0)wsf[32+r32]=l_reg;asm volatile("s_waitcnt lgkmcnt(0)":::"memory");
  float rli[16];
  #pragma unroll
  for(int r=0;r<16;++r)rli[r]=__builtin_amdgcn_rcpf(wsf[32+crow(r,hi)]);
  bf16*Ow=O+(rowbase+q0+wid*QBLK)*PO;
  { bf16*stg=(bf16*)(shm+LDS_OST)+wid*2048;
    #pragma unroll
    for(int r=0;r<16;++r){const int orow=crow(r,hi);
      #pragma unroll
      for(int d0=0;d0<2;++d0)stg[orow*64+d0*32+r32]=__float2bfloat16(o[d0][r]*rli[r]);}
    asm volatile("s_waitcnt lgkmcnt(0)":::"memory");
    #pragma unroll
    for(int i=0;i<4;++i){const int row=i*8+(lane>>3),ch=lane&7; const u32x4 v=*(const u32x4*)(stg+row*64+ch*8); ATTN_STORE16(Ow+(long)row*PO+ch*8,v);} }
  asm volatile("s_waitcnt lgkmcnt(0)\n\ts_barrier":::"memory");
  #undef DMA_K
  #undef DMA_V
  #undef CMASK
  #undef START
  #undef RESC
  #undef ROT
}
constexpr int ATTN_LDS_BYTES=LDS_BYTES;
struct AttnTensors { const bf16* P; bf16* O; };
struct AttnUnit { int b, h, c, vh, qb; };
struct StaticOrder {
  int vcu;
  __device__ __forceinline__ explicit StaticOrder(int vcu_):vcu(vcu_){}
  __device__ __forceinline__ bool next(int i,AttnUnit&u)const{ if(i>=8||vcu>=BATCH*NHEAD*8)return false; const int v=vcu,sub=i&7,s=v&7,bh=v>>3;
    u.b=bh>>3; u.h=bh&7; u.qb=(sub<4)?(NQB-1-s):s; u.c=(sub>>1)&1; u.vh=sub&1; return true; }
  __device__ __forceinline__ void a_ready(const AttnUnit&)const{}
  __device__ __forceinline__ void done(const AttnUnit&)const{}
};
template<class Sched,int THRL=8> __device__ __forceinline__ void attn_phase(char*lds,const AttnTensors&T,const Sched&S){
  AttnUnit u;
  for(int i=0;S.next(i,u);++i){ S.a_ready(u);
    attn_unit<THRL>(u.b,0,u.qb,T.P+u.h*128+u.c*64,T.P+1024+u.h*128+u.c*64,T.P+2048+u.h*128+u.vh*64,T.O+u.c*1024+u.h*128+u.vh*64,lds); S.done(u); }
}
#undef SBAR
#undef WAIT_BAR
}
namespace attn2 {
typedef unsigned short bf16;
typedef short bf16x8 __attribute__((ext_vector_type(8)));
typedef short s16x4 __attribute__((ext_vector_type(4)));
typedef float f32x16 __attribute__((ext_vector_type(16)));
typedef float f32x4 __attribute__((ext_vector_type(4)));
typedef unsigned u32x4 __attribute__((ext_vector_type(4)));
constexpr int NW = 8, QBLK = 32, KVBLK = 64, QB = NW * QBLK, DQ = 64, DV = 128, PQ = 7680, PO = 2048, SEQ = 4096, NQB = SEQ / QB;
constexpr int SHM_V = KVBLK * DV * 2, SHM_K = KVBLK * DQ * 2;
constexpr int LDS_WS = 2 * SHM_V + 2 * SHM_K, LDS_OST = LDS_WS + NW * 64 * 4, LDS_BYTES = LDS_OST + NW * QBLK * DV * 2;
constexpr float THR = 8.f;
#define A2_KSWZ(row, colB) ((row) * 128 + ((colB) ^ ((((row) >> 1) & 7) << 4)))
#define A2_SBAR() __builtin_amdgcn_sched_barrier(0)
__device__ __forceinline__ int v_st(int k, int c) { const int kk = (k & ~0xC) | ((k & 4) << 1) | ((k & 8) >> 1); return ((kk >> 3) * 4 + (c >> 5)) * 512 + ((kk & 7) * 32 + (c & 31)) * 2; }
__device__ __forceinline__ int v_rd_base(int lane) { return ((lane & 3) << 3) | (((lane >> 2) & 3) << 6) | (((lane >> 4) & 1) << 5) | (((lane >> 5) & 1) << 8); }
constexpr int v_rd_off(int d0, int ks, int half) { return d0 * 512 + ks * 4096 + half * 2048; }
__device__ __forceinline__ int crow(int r, int hi) { return (r & 3) + 8 * (r >> 2) + 4 * hi; }
__device__ __forceinline__ unsigned cvtpk(float lo, float hi) { unsigned r; asm volatile("v_cvt_pk_bf16_f32 %0, %1, %2" : "=v"(r) : "v"(lo), "v"(hi)); return r; }
__device__ __forceinline__ bf16x8 load8(const bf16* p) { return *reinterpret_cast<const bf16x8*>(p); }
__device__ __forceinline__ void mask_tile(f32x16& p0, f32x16& p1, int dq) {
    const float NEG = -__builtin_inff();
#pragma unroll
    for (int r = 0; r < 16; ++r) { const int c = (r & 3) + 8 * (r >> 2); if (dq - c < 0) p0[r] = NEG; if (dq - c - 32 < 0) p1[r] = NEG; }
}
__device__ __forceinline__ void partialSM(f32x16& p0, f32x16& p1, float& m_reg, float& mn, float& alpha) {
    float pmax = p0[0];
#pragma unroll
    for (int r = 1; r < 16; ++r) pmax = fmaxf(pmax, p0[r]);
#pragma unroll
    for (int r = 0; r < 16; ++r) pmax = fmaxf(pmax, p1[r]);
    { auto rr = __builtin_amdgcn_permlane32_swap(__float_as_uint(pmax), __float_as_uint(pmax), false, false); pmax = fmaxf(__uint_as_float(rr[0]), __uint_as_float(rr[1])); }
    if (__builtin_expect(__all((pmax - m_reg) <= THR), 1)) { mn = m_reg; alpha = 1.f; }
    else { mn = fmaxf(m_reg, pmax); alpha = __builtin_amdgcn_exp2f(m_reg - mn); m_reg = mn; }
#pragma unroll
    for (int r = 0; r < 16; ++r) p0[r] -= mn;
#pragma unroll
    for (int r = 0; r < 16; ++r) p1[r] -= mn;
#pragma unroll
    for (int r = 0; r < 16; ++r) p0[r] = __builtin_amdgcn_exp2f(p0[r]);
}
__device__ __forceinline__ void finishSM(f32x16& p0, f32x16& p1, float alpha, float& l_reg, bf16x8& pa0, bf16x8& pa1, bf16x8& pa2, bf16x8& pa3) {
#pragma unroll
    for (int r = 0; r < 16; ++r) p1[r] = __builtin_amdgcn_exp2f(p1[r]);
    float ps = 0;
#pragma unroll
    for (int r = 0; r < 16; ++r) ps += p0[r];
#pragma unroll
    for (int r = 0; r < 16; ++r) ps += p1[r];
    { auto rr = __builtin_amdgcn_permlane32_swap(__float_as_uint(ps), __float_as_uint(ps), false, false); ps = __uint_as_float(rr[0]) + __uint_as_float(rr[1]); }
    l_reg = l_reg * alpha + ps;
#define A2_PK4(P, B_, OUT) do { unsigned a0 = cvtpk(P[B_+0], P[B_+1]), a1 = cvtpk(P[B_+2], P[B_+3]); unsigned b0 = cvtpk(P[B_+4], P[B_+5]), b1 = cvtpk(P[B_+6], P[B_+7]); \
        auto r0 = __builtin_amdgcn_permlane32_swap(a0, b0, false, false); auto r1 = __builtin_amdgcn_permlane32_swap(a1, b1, false, false); \
        u32x4 w = {r0[0], r1[0], r0[1], r1[1]}; OUT = *reinterpret_cast<bf16x8*>(&w); } while (0)
    A2_PK4(p0, 0, pa0); A2_PK4(p0, 8, pa1); A2_PK4(p1, 0, pa2); A2_PK4(p1, 8, pa3);
#undef A2_PK4
}
template <int KB> __device__ __forceinline__ void kload(bf16x8* kf, const char* K_lds, int r32, int hi) {
#pragma unroll
    for (int d0 = 0; d0 < 4; ++d0) { const char* a = K_lds + KB * SHM_K + A2_KSWZ(r32, (d0 * 16 + hi * 8) * 2);
        kf[2 * d0] = *reinterpret_cast<const bf16x8*>(a); kf[2 * d0 + 1] = *reinterpret_cast<const bf16x8*>(a + 32 * 128); }
}
__device__ __forceinline__ void qkt(f32x16& p0, f32x16& p1, const bf16x8* kf, const bf16x8* qr) {
    p0 = f32x16{}; p1 = f32x16{};
#pragma unroll
    for (int d0 = 0; d0 < 4; ++d0) { p0 = __builtin_amdgcn_mfma_f32_32x32x16_bf16(kf[2 * d0], qr[d0], p0, 0, 0, 0); p1 = __builtin_amdgcn_mfma_f32_32x32x16_bf16(kf[2 * d0 + 1], qr[d0], p1, 0, 0, 0); }
}
template <int VB> __device__ __forceinline__ void pv_tile(f32x16* o, int vb0, bf16x8 pa0, bf16x8 pa1, bf16x8 pa2, bf16x8 pa3) {
#define A2_TRRD(dst, off) asm volatile("ds_read_b64_tr_b16 %0, %1 offset:%2" : "=&v"(dst) : "v"(vb0), "i"(off) : "memory")
#define A2_PV_D0(d0) do { s16x4 l0, l1, l2, l3, h0, h1, h2, h3; constexpr int b_ = VB * SHM_V + v_rd_off(d0, 0, 0); \
        A2_TRRD(l0, b_); A2_TRRD(h0, b_ + 2048); A2_TRRD(l1, b_ + 4096); A2_TRRD(h1, b_ + 6144); A2_TRRD(l2, b_ + 8192); A2_TRRD(h2, b_ + 10240); A2_TRRD(l3, b_ + 12288); A2_TRRD(h3, b_ + 14336); \
        asm volatile("s_waitcnt lgkmcnt(0)" ::: "memory"); A2_SBAR(); \
        o[d0] = __builtin_amdgcn_mfma_f32_32x32x16_bf16(pa0, (bf16x8){l0[0], l0[1], l0[2], l0[3], h0[0], h0[1], h0[2], h0[3]}, o[d0], 0, 0, 0); \
        o[d0] = __builtin_amdgcn_mfma_f32_32x32x16_bf16(pa1, (bf16x8){l1[0], l1[1], l1[2], l1[3], h1[0], h1[1], h1[2], h1[3]}, o[d0], 0, 0, 0); \
        o[d0] = __builtin_amdgcn_mfma_f32_32x32x16_bf16(pa2, (bf16x8){l2[0], l2[1], l2[2], l2[3], h2[0], h2[1], h2[2], h2[3]}, o[d0], 0, 0, 0); \
        o[d0] = __builtin_amdgcn_mfma_f32_32x32x16_bf16(pa3, (bf16x8){l3[0], l3[1], l3[2], l3[3], h3[0], h3[1], h3[2], h3[3]}, o[d0], 0, 0, 0); } while (0)
    A2_PV_D0(0); A2_PV_D0(1); A2_PV_D0(2); A2_PV_D0(3);
#undef A2_PV_D0
#undef A2_TRRD
}
struct BlockRef { const bf16* Q; const bf16* K; const bf16* V; const bf16* G; bf16* Mx; int P0; int mapc; };
#define A2_VMW() asm volatile("s_waitcnt vmcnt(0)" ::: "memory")
__device__ __forceinline__ void unit_block(const BlockRef& cur, char* lds, float lam, const float* sw, float osc) {
    int tid_ = threadIdx.x; asm volatile("" : "+v"(tid_)); const int tid = tid_, wid = __builtin_amdgcn_readfirstlane(tid >> 6), lane = tid & 63, r32 = lane & 31, hi = lane >> 5;
    const bool grpB = wid >= 4;
    const int NT = (cur.P0 + QB - 1) / KVBLK + 1;
    const int qlo = cur.P0 + wid * QBLK, qm = qlo + r32 - 4 * hi;
    char* V_lds = lds; char* K_lds = lds + 2 * SHM_V;
    float* ws = (float*)(lds + LDS_WS) + wid * 64; float* li_l = ws, * al_l = ws + 32;
    float m_reg = -1e30f, l_reg = 0; f32x16 o[4] = {};
    const int sr = tid >> 4, sc = (tid & 15) * 8, vst0 = v_st(sr, sc), vst1 = v_st(32 + sr, sc), kr = tid >> 3, kc = (tid & 7) * 8, kws = A2_KSWZ(kr, kc * 2);
    const int vb0 = (int)(uintptr_t)V_lds + v_rd_base(lane);
    const bf16* Kh = cur.K + (size_t)kr * PQ + kc; const bf16* Vh = cur.V + (size_t)sr * PQ + sc;
    bf16x8 qr[4], st_k, st_v0, st_v1;
#define A3_LDK(t) (st_k = load8(Kh + (size_t)(t) * KVBLK * PQ))
#define A3_LDV(t) do { st_v0 = load8(Vh + (size_t)(t) * KVBLK * PQ); st_v1 = load8(Vh + (size_t)((t) * KVBLK + 32) * PQ); } while (0)
#define A3_WRK(bf) (*(bf16x8*)(K_lds + (bf) * SHM_K + kws) = st_k)
#define A3_WRV(bf) do { *(bf16x8*)(V_lds + (bf) * SHM_V + vst0) = st_v0; *(bf16x8*)(V_lds + (bf) * SHM_V + vst1) = st_v1; } while (0)
#pragma unroll
    for (int d0 = 0; d0 < 4; ++d0) qr[d0] = load8(cur.Q + (size_t)(wid * QBLK + r32) * PQ + d0 * 16 + hi * 8);
    { A3_LDK(0); A3_LDV(0); const bf16x8 k1 = load8(Kh + (size_t)KVBLK * PQ); A2_VMW(); A3_WRK(0); A3_WRV(0); *(bf16x8*)(K_lds + SHM_K + kws) = k1; }
    A3_LDK(2); A3_LDV(1);
    __syncthreads();
    f32x16 p0, p1; float mn, alpha; bf16x8 pa0, pa1, pa2, pa3, kf[8];
#define A3_RESC(a) do { if (__any((a) < 1.f)) { if (hi == 0) al_l[r32] = (a); asm volatile("s_waitcnt lgkmcnt(0)" ::: "memory"); \
        _Pragma("unroll") for (int d_ = 0; d_ < 4; ++d_) _Pragma("unroll") for (int r = 0; r < 16; ++r) o[d_][r] *= al_l[crow(r, hi)]; } } while (0)
#define A3_SOFTMAX(t) do { const int kb_ = (t) * KVBLK; if (kb_ + KVBLK - 1 > qlo) mask_tile(p0, p1, qm - kb_); \
        partialSM(p0, p1, m_reg, mn, alpha); A3_RESC(alpha); finishSM(p0, p1, alpha, l_reg, pa0, pa1, pa2, pa3); } while (0)
#define A3_MFMA(t, KBN, VB) do { } while (0)
#define A3_STAGE(t, KBN, VB) do { A2_VMW(); A3_WRK(VB); A3_WRV(KBN); A2_SBAR(); { const int tk_ = (t) + 3 < NT ? (t) + 3 : NT - 1, tv_ = (t) + 2 < NT ? (t) + 2 : NT - 1; A3_LDK(tk_); A3_LDV(tv_); } A2_SBAR(); } while (0)
#undef A3_MFMA
#define A3_MFMA(t, KBN, VB) do { qkt(p0, p1, kf, qr); A2_SBAR(); pv_tile<VB>(o, vb0, pa0, pa1, pa2, pa3); } while (0)
#define A3_KL(KB) do { A2_SBAR(); kload<KB>(kf, K_lds, r32, hi); } while (0)
    if (!grpB) {
        kload<0>(kf, K_lds, r32, hi); qkt(p0, p1, kf, qr); __syncthreads();
        A3_SOFTMAX(0); A3_KL(1); __syncthreads();
        for (int t = 0; t < NT; t += 2) {
            A3_STAGE(t, 1, 0); A3_MFMA(t, 1, 0); __syncthreads(); A3_SOFTMAX(t + 1); A3_KL(0); __syncthreads();
            A3_STAGE(t + 1, 0, 1); A3_MFMA(t + 1, 0, 1); __syncthreads(); if (t + 2 < NT) { A3_SOFTMAX(t + 2); A3_KL(1); } __syncthreads();
        }
    } else {
        __syncthreads();
        kload<0>(kf, K_lds, r32, hi); qkt(p0, p1, kf, qr); __syncthreads();
        for (int t = 0; t < NT; t += 2) {
            A3_STAGE(t, 1, 0); A3_SOFTMAX(t); A3_KL(1); __syncthreads(); A3_MFMA(t, 1, 0); __syncthreads();
            A3_STAGE(t + 1, 0, 1); A3_SOFTMAX(t + 1); A3_KL(0); __syncthreads(); A3_MFMA(t + 1, 0, 1); __syncthreads();
        }
    }
    if (hi == 0) li_l[r32] = l_reg; asm volatile("s_waitcnt lgkmcnt(0)" ::: "memory");
    float rli[16];
#pragma unroll
    for (int r = 0; r < 16; ++r) rli[r] = __builtin_amdgcn_rcpf(li_l[crow(r, hi)]);
    { bf16* stg = (bf16*)(lds + LDS_OST) + wid * (QBLK * DV);
      if (cur.mapc == 0) {
#pragma unroll
        for (int r = 0; r < 16; ++r) { const int orow = crow(r, hi);
#pragma unroll
          for (int d0 = 0; d0 < 4; ++d0) { const float v = o[d0][r] * rli[r]; const unsigned u = __builtin_bit_cast(unsigned, v); stg[orow * DV + d0 * 32 + r32] = (bf16)((u + 0x7fffu + ((u >> 16) & 1u)) >> 16); } }
      } else {
        u32x4 gv[8]; const bf16* Gw = cur.G + (size_t)(wid * QBLK) * PQ;
#pragma unroll
        for (int i = 0; i < 8; ++i) gv[i] = *(const u32x4*)(Gw + (size_t)(i * 4 + (lane >> 4)) * PQ + (lane & 15) * 8);
        float swv[8];
#pragma unroll
        for (int j = 0; j < 8; ++j) swv[j] = sw[(lane & 15) * 8 + j] * osc;
#pragma unroll
        for (int r = 0; r < 16; ++r) { const int orow = crow(r, hi);
#pragma unroll
          for (int d0 = 0; d0 < 4; ++d0) { const int idx = orow * DV + d0 * 32 + r32; const float v = __uint_as_float((unsigned)stg[idx] << 16) - lam * (o[d0][r] * rli[r]);
            const unsigned u = __builtin_bit_cast(unsigned, v); stg[idx] = (bf16)((u + 0x7fffu + ((u >> 16) & 1u)) >> 16); } }
        asm volatile("s_waitcnt lgkmcnt(0)" ::: "memory");
        bf16* Mw = cur.Mx + (size_t)(wid * QBLK) * PO;
#pragma unroll
        for (int i = 0; i < 8; ++i) { const int row = i * 4 + (lane >> 4), ch = lane & 15; const u32x4 v = *(const u32x4*)(stg + row * DV + ch * 8);
          float d[8] = {__uint_as_float(v.x << 16), __uint_as_float(v.x & 0xffff0000u), __uint_as_float(v.y << 16), __uint_as_float(v.y & 0xffff0000u), __uint_as_float(v.z << 16), __uint_as_float(v.z & 0xffff0000u), __uint_as_float(v.w << 16), __uint_as_float(v.w & 0xffff0000u)};
          const u32x4 g = gv[i];
          const float gg[8] = {__uint_as_float(g.x << 16), __uint_as_float(g.x & 0xffff0000u), __uint_as_float(g.y << 16), __uint_as_float(g.y & 0xffff0000u), __uint_as_float(g.z << 16), __uint_as_float(g.z & 0xffff0000u), __uint_as_float(g.w << 16), __uint_as_float(g.w & 0xffff0000u)};
          float ss = 0.f;
#pragma unroll
          for (int j = 0; j < 8; ++j) ss += d[j] * d[j];
          ss += __int_as_float(__builtin_amdgcn_update_dpp(0, __float_as_int(ss), 0x128, 0xf, 0xf, false)); ss += __int_as_float(__builtin_amdgcn_update_dpp(0, __float_as_int(ss), 0x124, 0xf, 0xf, false));
          ss += __int_as_float(__builtin_amdgcn_update_dpp(0, __float_as_int(ss), 0x122, 0xf, 0xf, false)); ss += __int_as_float(__builtin_amdgcn_update_dpp(0, __float_as_int(ss), 0x121, 0xf, 0xf, false));
          const float rs = __builtin_amdgcn_rsqf(ss * (1.0f / 128.0f) + 1e-5f);
#pragma unroll
          for (int j = 0; j < 8; ++j) d[j] = d[j] * rs * swv[j] * gg[j];
          u32x4 w; w.x = cvtpk(d[0], d[1]); w.y = cvtpk(d[2], d[3]); w.z = cvtpk(d[4], d[5]); w.w = cvtpk(d[6], d[7]);
          *(u32x4*)(Mw + (size_t)row * PO + ch * 8) = w; }
      } }
    __syncthreads();
#undef A3_LDK
#undef A3_LDV
#undef A3_WRK
#undef A3_WRV
#undef A3_RESC
#undef A3_SOFTMAX
#undef A3_MFMA
#undef A3_STAGE
#undef A3_KL
}
#undef A2_VMW
struct AttnTensors { const bf16* P; bf16* Mx; };
__device__ __forceinline__ BlockRef unit_ref(const AttnTensors& T, int vcu, int i) {
    const int s = vcu & 7, bh = vcu >> 3, b = bh >> 3, h = bh & 7, c = i & 1, qb = (i & 2) ? s : (NQB - 1 - s);
    BlockRef r; const size_t row0 = (size_t)b * SEQ, rowq = row0 + (size_t)qb * QB;
    r.Q = T.P + rowq * PQ + h * 128 + c * 64; r.K = T.P + row0 * PQ + 1024 + h * 128 + c * 64; r.V = T.P + row0 * PQ + 2048 + h * 128;
    r.G = T.P + rowq * PQ + 3072 + h * 128; r.Mx = T.Mx + rowq * PO + h * 128; r.P0 = qb * QB; r.mapc = c; return r;
}
__device__ __forceinline__ void attn_phase(char* lds, const AttnTensors& T, int vcu, float lam, const float* sw, float osc) {
    if (vcu >= 256) return;
    for (int i = 0; i < 4; ++i) { const BlockRef cur = unit_ref(T, vcu, i); unit_block(cur, lds, lam, sw, osc); }
}
#undef A2_SBAR
#undef A2_KSWZ
}

constexpr int NWAVES = 8;
#ifndef ATTN_V2
#define ATTN_V2 1
#endif
#ifndef TAIL_COPIES
#define TAIL_COPIES 1
#endif
#ifndef MK_PER_PHASE
#define MK_PER_PHASE 0
#endif
constexpr int NPHASE = 8;

constexpr int BATCH = 4, SEQ = 4096, D = 2048, DEPTH = 2, NPROJ = 7680, NHEAD = 8;
constexpr int M = BATCH * SEQ;
constexpr float NORM_EPS = 1e-5f, LN_EPS = 1e-5f;
constexpr int PC_Q = 0, PC_K = 1024, PC_V = 2048, PC_GA = 3072, PC_U = 4096, PC_VS = 4608, PC_GB = 5120, PC_XC = 5632, PC_BG = 6144, PC_CG = 6656, PC_GC = 7168;

constexpr size_t MiB = 1u << 20;
constexpr size_t WS_CTL = 0, CTL_ZERO_BYTES = 1 * MiB;
constexpr size_t WS_SSQ1 = 256 * 1024;
constexpr size_t WS_SSQ0 = 1 * MiB;
constexpr size_t WS_ROPE = 2 * MiB;
constexpr size_t WS_TRIL = 3 * MiB;
constexpr size_t WS_WIN = 4 * MiB;
constexpr size_t WS_WOUT = 64 * MiB;
constexpr size_t WS_XB = 80 * MiB;
constexpr size_t WS_MIX = 144 * MiB;
constexpr size_t WS_PROJ = 208 * MiB;
constexpr size_t WS_END = 448 * MiB;
static_assert(WS_WIN + (size_t)DEPTH * NPROJ * D * 2 <= WS_WOUT && WS_WOUT + (size_t)DEPTH * D * D * 2 <= WS_XB && WS_XB + (size_t)M * D * 2 <= WS_MIX && WS_MIX + (size_t)M * D * 2 <= WS_PROJ && WS_PROJ + (size_t)M * NPROJ * 2 <= WS_END, "d_ws map");
constexpr int CW_BAR = 4096;

constexpr int RING_OFF = 0, RING_BYTES = 131072;
constexpr int LDSCTL_OFF = RING_BYTES, MISC_OFF = LDSCTL_OFF + 320;
constexpr int LDS_BYTES = 147456;
static_assert(MISC_OFF + 128 <= LDS_BYTES, "LDS map");

#define GAS __attribute__((address_space(1)))
#define LAS __attribute__((address_space(3)))
typedef unsigned short bf16;
typedef unsigned v4u __attribute__((ext_vector_type(4)));
typedef unsigned v2u __attribute__((ext_vector_type(2)));
typedef float f32x4 __attribute__((ext_vector_type(4)));
typedef short bf16x8 __attribute__((ext_vector_type(8)));
typedef GAS unsigned gu32;
#define RLX_AGENT __ATOMIC_RELAXED, __HIP_MEMORY_SCOPE_AGENT
#define LDS_WAIT() asm volatile("s_waitcnt lgkmcnt(0)" ::: "memory")
#define VM_WAIT() asm volatile("s_waitcnt vmcnt(0)" ::: "memory")
__device__ __forceinline__ unsigned f2bf(float f) { unsigned u = __builtin_bit_cast(unsigned, f); return (u + 0x7fffu + ((u >> 16) & 1u)) >> 16; }
__device__ __forceinline__ unsigned pk2(float lo, float hi) { return f2bf(lo) | (f2bf(hi) << 16); }
__device__ __forceinline__ float bflo(unsigned w) { return __uint_as_float(w << 16); }
__device__ __forceinline__ float bfhi(unsigned w) { return __uint_as_float(w & 0xffff0000u); }
__device__ __forceinline__ float bf1(bf16 b) { return __uint_as_float((unsigned)b << 16); }

#define XB_TMO      128
#define XB_XCNT(j)  (256  + 64 * (j))
#define XB_XSUB(j)  (1280 + 64 * (j))
#define XB_XGEN(j)  (2304 + 64 * (j))
#define XB_TOP      3328
#define XB_TOPGEN   3392
#define XCD_BAR_WORDS 3456
#define XB_SPIN_CAP (1u << 18)

__device__ __forceinline__ unsigned xb_ld(unsigned* p)              { return __hip_atomic_load(p, __ATOMIC_RELAXED, __HIP_MEMORY_SCOPE_AGENT); }
__device__ __forceinline__ unsigned xb_add(unsigned* p, unsigned v) { return __hip_atomic_fetch_add(p, v, __ATOMIC_RELAXED, __HIP_MEMORY_SCOPE_AGENT); }
__device__ __forceinline__ unsigned xb_xcc_id() { return (unsigned)__builtin_amdgcn_s_getreg((3 << 11) | 20) & 0xFu; }
#define XB_SPIN(cond, bar) do { unsigned _sp = 0; while (cond) { __builtin_amdgcn_s_sleep(1); \
    if ((++_sp & 255u) == 0u) { if (xb_ld(&(bar)[XB_TMO])) break; if (_sp > XB_SPIN_CAP) { atomicAdd(&(bar)[XB_TMO], 1u); break; } } } } while (0)

struct XcdBarrier {
    unsigned* bar; unsigned x;
    volatile LAS unsigned* st;
};

__device__ __forceinline__ XcdBarrier xcd_barrier_post(unsigned* bar, volatile LAS unsigned* st) {
    XcdBarrier b; b.bar = bar; b.x = xb_xcc_id(); b.st = st;
    if (threadIdx.x == 0) (void)xb_add(&bar[XB_XCNT(b.x)], 1u);
    return b;
}
__device__ __forceinline__ void xcd_barrier_complete(unsigned* bar, unsigned x, unsigned& nloc, unsigned& nx) {
    const unsigned G = gridDim.x * gridDim.y * gridDim.z;
    unsigned sum, cnt, mine, sp = 0u;
    for (;;) {
        sum = 0u; cnt = 0u; mine = 0u;
#pragma unroll
        for (unsigned j = 0; j < 16; ++j) { const unsigned c = xb_ld(&bar[XB_XCNT(j)]); sum += c; cnt += (c > 0u) ? 1u : 0u; mine = (j == x) ? c : mine; }
        if (sum == G) break;
        __builtin_amdgcn_s_sleep(1);
        if ((++sp & 255u) == 0u) { if (xb_ld(&bar[XB_TMO])) break; if (sp > XB_SPIN_CAP) { atomicAdd(&bar[XB_TMO], 1u); break; } }
    }
    nloc = mine > 0u ? mine : 1u; nx = cnt > 0u ? cnt : 1u;
}

__device__ __forceinline__ void xcd_barrier(const XcdBarrier& b) {
    asm volatile("s_waitcnt vmcnt(0)" ::: "memory");
    __syncthreads();
    if (threadIdx.x == 0) {
        unsigned* bar = b.bar;
        __builtin_amdgcn_s_waitcnt(0);
        unsigned nloc = b.st[0], nx = b.st[1];
        if (nloc == 0u) { xcd_barrier_complete(bar, b.x, nloc, nx); b.st[0] = nloc; b.st[1] = nx; }
        const unsigned old = xb_add(&bar[XB_XSUB(b.x)], 1u);
        const unsigned gen = old / nloc;
        if (old + 1u == (gen + 1u) * nloc) {
            __builtin_amdgcn_fence(__ATOMIC_RELEASE, "agent");
            asm volatile("s_waitcnt vmcnt(0)" ::: "memory");
            const unsigned og = xb_add(&bar[XB_TOP], 1u);
            const unsigned tg = og / nx;
            if (og + 1u == (tg + 1u) * nx) xb_add(&bar[XB_TOPGEN], 1u);
            else XB_SPIN(xb_ld(&bar[XB_TOPGEN]) == tg, bar);
            __builtin_amdgcn_fence(__ATOMIC_ACQUIRE, "agent");
            xb_add(&bar[XB_XGEN(b.x)], 1u);
            asm volatile("s_waitcnt vmcnt(0)" ::: "memory");
        } else {
            XB_SPIN(xb_ld(&bar[XB_XGEN(b.x)]) == gen, bar);
            __builtin_amdgcn_fence(__ATOMIC_ACQUIRE, "agent");
            asm volatile("s_waitcnt vmcnt(0)" ::: "memory");
        }
    }
    __syncthreads();
}

struct Frame {
    LAS unsigned char* lds;
    int tid, lane, wave;
    int vcu, G;
};
__device__ __forceinline__ void frame_ids(Frame& F) {
    int t = threadIdx.x; asm volatile("" : "+v"(t));
    F.tid = t; F.lane = t & 63; F.wave = __builtin_amdgcn_readfirstlane(t >> 6);
    int bx = blockIdx.x; asm volatile("" : "+s"(bx));
    F.G = gridDim.x; F.vcu = (F.G % 8 == 0) ? (bx % 8) * (F.G / 8) + bx / 8 : bx;
}

template <int CTRL> __device__ __forceinline__ float dpp_f(float v) { return __int_as_float(__builtin_amdgcn_update_dpp(0, __float_as_int(v), CTRL, 0xf, 0xf, false)); }
__device__ __forceinline__ float row16_sum(float v) { v += dpp_f<0x128>(v); v += dpp_f<0x124>(v); v += dpp_f<0x122>(v); v += dpp_f<0x121>(v); return v; }
__device__ __forceinline__ float wave_sum(float v) {
    v = row16_sum(v);
    const int vi = __float_as_int(v);
    const float a = __int_as_float(__builtin_amdgcn_readlane(vi, 0)), b = __int_as_float(__builtin_amdgcn_readlane(vi, 16)), c = __int_as_float(__builtin_amdgcn_readlane(vi, 32)), d = __int_as_float(__builtin_amdgcn_readlane(vi, 48));
    return (a + b) + (c + d);
}
__device__ __forceinline__ int qk_dest_row(int n) { if (n >= 2048) return n; const int v = n >> 6, d = n & 63; const int j = (d < 32) ? ((d >> 2) * 8 + (d & 3)) : (((d - 32) >> 2) * 8 + 4 + (d & 3)); return (v << 6) + j; }
__device__ __forceinline__ void p0_transpose_item(const float* W, int K, int N, bf16* WT, const float* kscale, bool perm, int item, int lane) {
    const int nblk = N / 64, kb = item / nblk, nb = item % nblk, k0 = 64 * kb, n = 64 * nb + lane;
    const GAS float* src = (const GAS float*)W + (size_t)k0 * N + n;
    float v[64];
#pragma unroll
    for (int i = 0; i < 64; ++i) v[i] = src[(size_t)i * N];
    if (kscale) {
#pragma unroll
        for (int i = 0; i < 64; ++i) v[i] *= kscale[k0 + i];
    }
    const int nd = perm ? qk_dest_row(n) : n;
    GAS v4u* dst = (GAS v4u*)(WT + (size_t)nd * K + k0);
#pragma unroll
    for (int j = 0; j < 8; ++j) { v4u o; o.x = pk2(v[8 * j], v[8 * j + 1]); o.y = pk2(v[8 * j + 2], v[8 * j + 3]); o.z = pk2(v[8 * j + 4], v[8 * j + 5]); o.w = pk2(v[8 * j + 6], v[8 * j + 7]); dst[j] = o; }
}
struct Args { const float* in[15]; float* out; unsigned char* ws; int ph_lo, ph_hi; };
typedef const __attribute__((address_space(4))) Args* KArgs;
__device__ __forceinline__ KArgs kargs() { KArgs p = (KArgs)__builtin_amdgcn_kernarg_segment_ptr(); asm volatile("" : "+s"(p)); return p; }
enum { I_X = 0, I_NORMW, I_WIN, I_LQ1, I_LK1, I_LQ2, I_LK2, I_SUBLN, I_LNG, I_LNB, I_WS, I_BS, I_CONVW, I_WOUT, I_FINALW };
constexpr int I_IN = (D / 64) * (NPROJ / 64), I_OUT = (D / 64) * (D / 64), I_LAYER = I_IN + I_OUT;
__device__ __forceinline__ void weight_items(Frame& F, int lo, int hi, int w, int nw) {
    KArgs ka = kargs(); unsigned char* const ws = ka->ws;
    bf16* win = (bf16*)(ws + WS_WIN); bf16* wout = (bf16*)(ws + WS_WOUT);
    const float* w_in = ka->in[I_WIN]; const float* w_out = ka->in[I_WOUT]; const float* norm_w = ka->in[I_NORMW];
    for (int it = lo + w; it < hi; it += nw) {
        int r = it; const int l = r / I_LAYER; r -= l * I_LAYER;
        if (r < I_IN) p0_transpose_item(w_in + (size_t)l * D * NPROJ, D, NPROJ, win + (size_t)l * NPROJ * D, norm_w + l * D, true, r, F.lane);
        else p0_transpose_item(w_out + (size_t)l * D * D, D, D, wout + (size_t)l * D * D, nullptr, false, r - I_IN, F.lane);
    }
}
__device__ __forceinline__ void p0_prologue(Frame& F) {
    KArgs ka = kargs(); unsigned char* const ws = ka->ws;
    const int gw = F.vcu * NWAVES + F.wave, NGW = F.G * NWAVES;
    weight_items(F, 0, TAIL_COPIES ? I_IN : DEPTH * I_LAYER, gw, NGW);
    bf16* xb = (bf16*)(ws + WS_XB); float* ssq0 = (float*)(ws + WS_SSQ0); const float* x = ka->in[I_X];
    for (int m0 = gw * 2; m0 < M; m0 += NGW * 2) {
        f32x4 v[2][8];
#pragma unroll
        for (int i = 0; i < 2; ++i)
#pragma unroll
            for (int j = 0; j < 8; ++j) v[i][j] = ((const GAS f32x4*)(x + (size_t)(m0 + i) * D))[64 * j + F.lane];
#pragma unroll
        for (int i = 0; i < 2; ++i) { float s = 0.f;
            GAS unsigned long long* o8 = (GAS unsigned long long*)(xb + (size_t)(m0 + i) * D) + F.lane;
#pragma unroll
            for (int j = 0; j < 8; ++j) { s += (v[i][j].x * v[i][j].x + v[i][j].y * v[i][j].y) + (v[i][j].z * v[i][j].z + v[i][j].w * v[i][j].w);
                o8[64 * j] = (unsigned long long)pk2(v[i][j].x, v[i][j].y) | ((unsigned long long)pk2(v[i][j].z, v[i][j].w) << 32); }
            s = wave_sum(s);
            if (F.lane == 0) ssq0[m0 + i] = s; }
    }
    const int gt = F.vcu * (NWAVES * 64) + F.tid, NGT = F.G * NWAVES * 64;
    float* rope = (float*)(ws + WS_ROPE);
    for (int e = gt; e < SEQ * 32; e += NGT) {
        const int pos = e >> 5, i = e & 31;
        double f = 1.0; for (int k = 0; k < i; ++k) f *= 0.74989420933245582730;
        const double rev = (double)pos * f * 0.15915494309189533577; const double fr = rev - __builtin_floor(rev);
        rope[pos * 64 + i] = __builtin_amdgcn_cosf((float)fr); rope[pos * 64 + 32 + i] = __builtin_amdgcn_sinf((float)fr);
    }
    bf16* tril = (bf16*)(ws + WS_TRIL); const float* w_s = ka->in[I_WS];
    for (int e = gt; e < DEPTH * 4 * 128 * 128; e += NGT) { const int s = e & 127, t = (e >> 7) & 127; tril[e] = (s <= t) ? (bf16)f2bf(w_s[e]) : (bf16)0; }
}

__device__ __forceinline__ void unpack8(const v4u w, float (&f)[8]) { f[0] = bflo(w.x); f[1] = bfhi(w.x); f[2] = bflo(w.y); f[3] = bfhi(w.y); f[4] = bflo(w.z); f[5] = bfhi(w.z); f[6] = bflo(w.w); f[7] = bfhi(w.w); }
__device__ __forceinline__ v4u pack8(const float (&f)[8]) { v4u w; w.x = pk2(f[0], f[1]); w.y = pk2(f[2], f[3]); w.z = pk2(f[4], f[5]); w.w = pk2(f[6], f[7]); return w; }
__device__ __forceinline__ void sgu_item(Frame& F, unsigned char* ws, const float* ln_g, const float* ln_b, const float* b_s, int layer, int item) {
    const int chunk = item >> 2, g = item & 3, row0 = chunk * 128, lane = F.lane, wave = F.wave;
    const bf16* proj = (const bf16*)(ws + WS_PROJ); bf16* mix = (bf16*)(ws + WS_MIX);
    LAS bf16* vnT = (LAS bf16*)(F.lds + RING_OFF);
    const float g0 = ln_g[layer * 512 + g * 128 + lane], g1 = ln_g[layer * 512 + g * 128 + 64 + lane], b0 = ln_b[layer * 512 + g * 128 + lane], b1 = ln_b[layer * 512 + g * 128 + 64 + lane];
#pragma unroll
    for (int hb = 0; hb < 2; ++hb) {
        v4u raw[8]; bf16 e0[8], e1[8];
#pragma unroll
        for (int tt = 0; tt < 8; ++tt) { const bf16* rp = proj + (size_t)(row0 + 16 * wave + 8 * hb + tt) * NPROJ + PC_VS;
            raw[tt] = *(const GAS v4u*)(rp + 8 * lane); e0[tt] = rp[g * 128 + lane]; e1[tt] = rp[g * 128 + 64 + lane]; }
#pragma unroll
        for (int tt = 0; tt < 8; ++tt) { const int tl = 16 * wave + 8 * hb + tt;
            float f[8]; unpack8(raw[tt], f);
            float s1 = ((f[0] + f[1]) + (f[2] + f[3])) + ((f[4] + f[5]) + (f[6] + f[7]));
            const float mean = wave_sum(s1) * (1.0f / 512.0f); float s2 = 0.f;
#pragma unroll
            for (int j = 0; j < 8; ++j) { const float d = f[j] - mean; s2 += d * d; }
            const float rstd = __builtin_amdgcn_rsqf(wave_sum(s2) * (1.0f / 512.0f) + LN_EPS);
            vnT[lane * 136 + tl] = (bf16)f2bf((bf1(e0[tt]) - mean) * rstd * g0 + b0);
            vnT[(64 + lane) * 136 + tl] = (bf16)f2bf((bf1(e1[tt]) - mean) * rstd * g1 + b1); }
    }
    LDS_WAIT(); __syncthreads();
    bf16x8 a[4];
#pragma unroll
    for (int ks = 0; ks < 4; ++ks) a[ks] = *(const LAS bf16x8*)(vnT + (16 * wave + (lane & 15)) * 136 + 32 * ks + 8 * (lane >> 4));
    const bf16* tril = (const bf16*)(ws + WS_TRIL) + (size_t)(layer * 4 + g) * 128 * 128;
#pragma unroll
    for (int th = 0; th < 2; ++th) {
        bf16x8 b[4][4]; v2u u2[4], s2[4]; float bs[4];
#pragma unroll
        for (int q = 0; q < 4; ++q) { const int t = 16 * (4 * th + q) + (lane & 15), row = row0 + t, ch4 = g * 128 + 16 * wave + 4 * (lane >> 4);
#pragma unroll
            for (int ks = 0; ks < 4; ++ks) b[q][ks] = *(const GAS bf16x8*)(tril + t * 128 + 32 * ks + 8 * (lane >> 4));
            u2[q] = *(const GAS v2u*)(proj + (size_t)row * NPROJ + PC_U + ch4); s2[q] = *(const GAS v2u*)(proj + (size_t)row * NPROJ + PC_GB + ch4); bs[q] = b_s[(layer * 4 + g) * 128 + t]; }
#pragma unroll
        for (int q = 0; q < 4; ++q) { const int t = 16 * (4 * th + q) + (lane & 15), row = row0 + t, ch4 = g * 128 + 16 * wave + 4 * (lane >> 4);
            f32x4 acc = (f32x4){0.f, 0.f, 0.f, 0.f};
#pragma unroll
            for (int ks = 0; ks < 4; ++ks) acc = __builtin_amdgcn_mfma_f32_16x16x32_bf16(a[ks], b[q][ks], acc, 0, 0, 0);
            v2u o; o.x = pk2(bflo(u2[q].x) * (acc[0] + bs[q]) * bflo(s2[q].x), bfhi(u2[q].x) * (acc[1] + bs[q]) * bfhi(s2[q].x)); o.y = pk2(bflo(u2[q].y) * (acc[2] + bs[q]) * bflo(s2[q].y), bfhi(u2[q].y) * (acc[3] + bs[q]) * bfhi(s2[q].y));
            *(GAS v2u*)(mix + (size_t)row * D + 1024 + ch4) = o; }
    }
    LDS_WAIT(); __syncthreads();
}
__device__ __forceinline__ float lam_of(KArgs ka, int layer, int lane) {
    const float a = wave_sum(ka->in[I_LQ1][layer * 64 + lane] * ka->in[I_LK1][layer * 64 + lane]), b = wave_sum(ka->in[I_LQ2][layer * 64 + lane] * ka->in[I_LK2][layer * 64 + lane]);
    const float lam_init = 0.8f - 0.6f * __expf(-0.3f * (float)layer);
    return __expf(a) - __expf(b) + lam_init;
}
__device__ __forceinline__ void mix_phase(Frame& F, int layer) {
    KArgs ka = kargs(); unsigned char* const ws = ka->ws;
    { const float* ln_g = ka->in[I_LNG]; const float* ln_b = ka->in[I_LNB]; const float* b_s = ka->in[I_BS];
      for (int it = F.vcu; it < 512; it += F.G) sgu_item(F, ws, ln_g, ln_b, b_s, layer, it); }
    const bf16* proj = (const bf16*)(ws + WS_PROJ); bf16* mix = (bf16*)(ws + WS_MIX); const bf16* atto = (const bf16*)ka->out;
    const float* subln_w = ka->in[I_SUBLN]; const float* conv_w = ka->in[I_CONVW];
    const int lane = F.lane, gw = F.vcu * NWAVES + F.wave, NGW = F.G * NWAVES;
    const float lam_init = 0.8f - 0.6f * __expf(-0.3f * (float)layer), lam = lam_of(ka, layer, lane);
    for (int blk = gw; blk < M / 8; blk += NGW) {
        const int r0 = blk * 8;
#if !ATTN_V2
        { float sw[8];
#pragma unroll
          for (int j = 0; j < 8; ++j) sw[j] = subln_w[layer * 128 + 8 * (lane & 15) + j] * (1.0f - lam_init);
#pragma unroll
          for (int hb = 0; hb < 2; ++hb) {
            v4u r1[4][2], r2[4][2], rg[4][2];
#pragma unroll
            for (int i = 0; i < 4; ++i)
#pragma unroll
                for (int hf = 0; hf < 2; ++hf) { const int row = r0 + 4 * hb + i, col = hf * 512 + 8 * lane;
                    r1[i][hf] = *(const GAS v4u*)(atto + (size_t)row * D + col); r2[i][hf] = *(const GAS v4u*)(atto + (size_t)row * D + 1024 + col); rg[i][hf] = *(const GAS v4u*)(proj + (size_t)row * NPROJ + PC_GA + col); }
#pragma unroll
            for (int i = 0; i < 4; ++i)
#pragma unroll
                for (int hf = 0; hf < 2; ++hf) { const int row = r0 + 4 * hb + i, col = hf * 512 + 8 * lane;
                    float o1[8], o2[8], sg[8], y[8]; unpack8(r1[i][hf], o1); unpack8(r2[i][hf], o2); unpack8(rg[i][hf], sg);
                    float ss = 0.f;
#pragma unroll
                    for (int j = 0; j < 8; ++j) { o1[j] -= lam * o2[j]; ss += o1[j] * o1[j]; }
                    const float rs = __builtin_amdgcn_rsqf(row16_sum(ss) * (1.0f / 128.0f) + NORM_EPS);
#pragma unroll
                    for (int j = 0; j < 8; ++j) y[j] = o1[j] * rs * sw[j] * sg[j];
                    *(GAS v4u*)(mix + (size_t)row * D + col) = pack8(y); }
          } }
#endif
        { float cw0[8], cw1[8], cw2[8];
#pragma unroll
          for (int j = 0; j < 8; ++j) { cw0[j] = conv_w[(layer * 3 + 0) * 512 + 8 * lane + j]; cw1[j] = conv_w[(layer * 3 + 1) * 512 + 8 * lane + j]; cw2[j] = conv_w[(layer * 3 + 2) * 512 + 8 * lane + j]; }
#pragma unroll
          for (int hb = 0; hb < 2; ++hb) { const int rb = r0 + 4 * hb; const bool halo = (rb & (SEQ - 1)) != 0;
            v4u rx[6], rc[6], rbg[4], rgc[4];
#pragma unroll
            for (int i = 0; i < 6; ++i) { const int row = (halo || i >= 2) ? rb - 2 + i : rb; const bf16* rp = proj + (size_t)row * NPROJ + 8 * lane; rx[i] = *(const GAS v4u*)(rp + PC_XC); rc[i] = *(const GAS v4u*)(rp + PC_CG); }
#pragma unroll
            for (int i = 0; i < 4; ++i) { const bf16* rp = proj + (size_t)(rb + i) * NPROJ + 8 * lane; rbg[i] = *(const GAS v4u*)(rp + PC_BG); rgc[i] = *(const GAS v4u*)(rp + PC_GC); }
            float z[6][8];
#pragma unroll
            for (int i = 0; i < 6; ++i) { float a[8], b[8]; unpack8(rx[i], a); unpack8(rc[i], b);
#pragma unroll
                for (int j = 0; j < 8; ++j) z[i][j] = (halo || i >= 2) ? a[j] * b[j] : 0.f; }
#pragma unroll
            for (int i = 0; i < 4; ++i) { float bg[8], gc[8], y[8]; unpack8(rbg[i], bg); unpack8(rgc[i], gc);
#pragma unroll
                for (int j = 0; j < 8; ++j) y[j] = bg[j] * (cw0[j] * z[i][j] + cw1[j] * z[i + 1][j] + cw2[j] * z[i + 2][j]) * gc[j];
                *(GAS v4u*)(mix + (size_t)(rb + i) * D + 1536 + 8 * lane) = pack8(y); }
          } }
    }
}
__device__ __forceinline__ void final_norm(Frame& F) {
    KArgs ka = kargs(); float* const out = ka->out; const float* final_w = ka->in[I_FINALW]; const bf16* xb = (const bf16*)(ka->ws + WS_XB);
    const int gw = F.vcu * NWAVES + F.wave, NGW = F.G * NWAVES;
    for (int m0 = gw * 4; m0 < M; m0 += NGW * 4) {
        v4u raw[4][4];
#pragma unroll
        for (int i = 0; i < 4; ++i)
#pragma unroll
            for (int j = 0; j < 4; ++j) raw[i][j] = ((const GAS v4u*)(xb + (size_t)(m0 + i) * D))[64 * j + F.lane];
#pragma unroll
        for (int i = 0; i < 4; ++i) { float v[4][8]; float s = 0.f;
#pragma unroll
            for (int j = 0; j < 4; ++j) { unpack8(raw[i][j], v[j]);
#pragma unroll
                for (int e = 0; e < 8; ++e) s += v[j][e] * v[j][e]; }
            const float rs = __builtin_amdgcn_rsqf(wave_sum(s) * (1.0f / 2048.0f) + NORM_EPS);
            GAS f32x4* orow = (GAS f32x4*)(out + (size_t)(m0 + i) * D);
#pragma unroll
            for (int j = 0; j < 4; ++j) { const f32x4 w0 = ((const GAS f32x4*)final_w)[128 * j + 2 * F.lane], w1 = ((const GAS f32x4*)final_w)[128 * j + 2 * F.lane + 1];
                orow[128 * j + 2 * F.lane] = (f32x4){v[j][0] * rs * w0.x, v[j][1] * rs * w0.y, v[j][2] * rs * w0.z, v[j][3] * rs * w0.w};
                orow[128 * j + 2 * F.lane + 1] = (f32x4){v[j][4] * rs * w1.x, v[j][5] * rs * w1.y, v[j][6] * rs * w1.z, v[j][7] * rs * w1.w}; }
        }
    }
}

__global__ void __launch_bounds__(NWAVES * 64, 2) hybrid_fwd(Args args) {
    extern __shared__ __attribute__((aligned(16))) unsigned char lds[];
    Frame F;
    F.lds = (LAS unsigned char*)lds;
    volatile LAS unsigned* MISC = (volatile LAS unsigned*)(F.lds + MISC_OFF);
    for (int u = threadIdx.x; u < (LDS_BYTES - LDSCTL_OFF) / 4; u += NWAVES * 64) ((LAS unsigned*)(F.lds + LDSCTL_OFF))[u] = 0u;
    __syncthreads();
    XcdBarrier bar; bar.bar = (unsigned*)(args.ws + WS_CTL) + CW_BAR; bar.x = 0; bar.st = nullptr;
    if (!MK_PER_PHASE) bar = xcd_barrier_post((unsigned*)(args.ws + WS_CTL) + CW_BAR, MISC + 8);
    const int lo = args.ph_lo, hi = args.ph_hi;
#ifndef PH_MASK
#define PH_MASK 0x3f
#endif
#define IN(k) (lo <= (k) && (k) < hi)
#define EN(b) ((PH_MASK >> (b)) & 1)
#ifndef REP_MASK
#define REP_MASK 0
#endif
#define NREP(b) (((REP_MASK >> (b)) & 1) + 1)
#define SEAM(k) do { if (IN(k) && IN((k) + 1)) xcd_barrier(bar); } while (0)

    if (EN(0) && IN(0)) { for (int rep = 0; rep < NREP(0); ++rep) { if (rep) xcd_barrier(bar); frame_ids(F); p0_prologue(F); } } SEAM(0);
    for (int layer = 0; layer < DEPTH; ++layer) {
        const int pb = 1 + 3 * layer;
        if (EN(1) && IN(pb)) for (int rep = 0; rep < NREP(1); ++rep) {
            if (rep) xcd_barrier(bar);
            unsigned char* const ws = kargs()->ws;
            pg8::Gemm g{(const pg8::bf16_t*)(ws + WS_XB), (const pg8::bf16_t*)(ws + WS_WIN) + (size_t)layer * NPROJ * D, M, NPROJ, D};
            pg8::StaticOrder S; S.init(M, NPROJ, (int)gridDim.x, (int)blockIdx.x);
            pg8::EpiProj E{(pg8::bf16_t*)(ws + WS_PROJ), (const float*)(ws + (layer == 0 ? WS_SSQ0 : WS_SSQ1)), (const float*)(ws + WS_ROPE)};
            pg8::gemm_phase<pg8::EpiProj, pg8::StaticOrder, PG8_ALIGN, PG8_SP2>(F.lds + RING_OFF, g, S, E);
            if (TAIL_COPIES && rep == 0) {
                const int G_ = (int)gridDim.x, nwg = (M / 256) * (NPROJ / 256), full = nwg % G_;
                if (full != 0 && (int)blockIdx.x >= full) { frame_ids(F); const int w = ((int)blockIdx.x - full) * NWAVES + F.wave, nw = (G_ - full) * NWAVES;
                    if (layer == 0) weight_items(F, I_IN, I_LAYER + I_IN, w, nw); else weight_items(F, I_LAYER + I_IN, 2 * I_LAYER, w, nw); }
                else if (full == 0 && layer == 0) { frame_ids(F); weight_items(F, I_IN, 2 * I_LAYER, F.vcu * NWAVES + F.wave, F.G * NWAVES); }
            }
        }
        SEAM(pb);
        if (IN(pb + 1)) for (int rep = 0; rep < NREP(2) + NREP(3) - 1; ++rep) {
            if (rep) xcd_barrier(bar);
            frame_ids(F); const bool mix_first = (F.vcu & 1) == 0;
            for (int st = 0; st < 2; ++st) {
                if ((st == 0) == mix_first) { if (EN(3) && (rep == 0 || NREP(3) == 2)) { frame_ids(F); mix_phase(F, layer); } }
                else if (EN(2) && (rep == 0 || NREP(2) == 2)) {
                    KArgs ka = kargs(); unsigned char* const ws = ka->ws; frame_ids(F);
                    const float lam_init = 0.8f - 0.6f * __expf(-0.3f * (float)layer), lam = lam_of(ka, layer, F.lane);
                    const attn2::AttnTensors AT{(const attn2::bf16*)(ws + WS_PROJ), (attn2::bf16*)(ws + WS_MIX)};
                    attn2::attn_phase((char*)lds + RING_OFF, AT, F.vcu, lam, ka->in[I_SUBLN] + layer * 128, 1.0f - lam_init);
                }
            }
        }
        SEAM(pb + 1);
        if (EN(4) && IN(pb + 2)) for (int rep = 0; rep < (layer == 0 ? NREP(4) : 1); ++rep) {
            if (rep) xcd_barrier(bar);
            KArgs ka = kargs(); unsigned char* const ws = ka->ws; const float* xin = ka->in[I_X];
            pg8::Gemm g{(const pg8::bf16_t*)(ws + WS_MIX), (const pg8::bf16_t*)(ws + WS_WOUT) + (size_t)layer * D * D, M, D, D};
            pg8::StaticOrder S; S.init(M, D, (int)gridDim.x, (int)blockIdx.x);
            pg8::EpiResid E{layer == 0 ? xin : nullptr, layer == 0 ? nullptr : (const pg8::bf16_t*)(ws + WS_XB), (pg8::bf16_t*)(ws + WS_XB), (layer == 0 && rep == 0) ? (float*)(ws + WS_SSQ1) : nullptr};
            pg8::gemm_phase<pg8::EpiResid, pg8::StaticOrder, PG8_ALIGN, PG8_SP2>(F.lds + RING_OFF, g, S, E);
        }
        SEAM(pb + 2);
    }
    if (EN(5) && IN(7)) { frame_ids(F); final_norm(F); }
#undef IN
#undef SEAM
}

extern "C" void kernel_launch(void* const* d_in, const int* in_sizes, int n_in, void* d_out, int out_size, void* d_ws, size_t ws_size, hipStream_t stream) {
    static int grid = 0;
    if (grid == 0) {
        if (n_in != 15 || in_sizes[0] != M * D || out_size != M * D || ws_size < WS_END) { fprintf(stderr, "kernel_launch: shape/workspace mismatch (n_in %d, in0 %d, out %d, ws %zu); nothing launched\n", n_in, n_in > 0 ? in_sizes[0] : -1, out_size, ws_size); grid = -1; return; }
        int dev = 0, cus = 0, per_cu = 0;
        if (hipGetDevice(&dev) != hipSuccess || hipDeviceGetAttribute(&cus, hipDeviceAttributeMultiprocessorCount, dev) != hipSuccess) { grid = -1; return; }
        if (hipFuncSetAttribute((const void*)hybrid_fwd, hipFuncAttributeMaxDynamicSharedMemorySize, LDS_BYTES) != hipSuccess) { fprintf(stderr, "kernel_launch: hipFuncSetAttribute failed\n"); grid = -1; return; }
        if (hipOccupancyMaxActiveBlocksPerMultiprocessor(&per_cu, (const void*)hybrid_fwd, NWAVES * 64, LDS_BYTES) != hipSuccess || per_cu < 1)
            fprintf(stderr, "kernel_launch: note: occupancy query reports %d workgroups per CU\n", per_cu);
        (void)hipGetLastError();
        grid = cus;
    }
    if (grid < 0) return;
    if (hipMemsetAsync((char*)d_ws + WS_CTL, 0, CTL_ZERO_BYTES, stream) != hipSuccess) { fprintf(stderr, "kernel_launch: hipMemsetAsync failed\n"); return; }
    Args a{};
    for (int i = 0; i < 15; ++i) a.in[i] = (const float*)d_in[i];
    a.out = (float*)d_out; a.ws = (unsigned char*)d_ws;
#if MK_PER_PHASE
    for (int p = 0; p < NPHASE; ++p) { a.ph_lo = p; a.ph_hi = p + 1; hipLaunchKernelGGL(hybrid_fwd, dim3(grid), dim3(NWAVES * 64), LDS_BYTES, stream, a); }
#else
    a.ph_lo = 0; a.ph_hi = NPHASE;
    hipLaunchKernelGGL(hybrid_fwd, dim3(grid), dim3(NWAVES * 64), LDS_BYTES, stream, a);
#endif
    const hipError_t le = hipPeekAtLastError();
    if (le != hipSuccess) fprintf(stderr, "kernel_launch: launch failed: %s\n", hipGetErrorName(le));
}
```

```cpp
#include <hip/hip_runtime.h>
#include <cstdio>
#include <cstdint>
namespace pg8 {
#define PG8_LAS __attribute__((address_space(3)))
typedef unsigned short bf16_t;
typedef short bf16x8 __attribute__((ext_vector_type(8)));
typedef float f32x4 __attribute__((ext_vector_type(4)));
typedef unsigned u32x4 __attribute__((ext_vector_type(4)));
constexpr int BM = 256, BK = 64, HALF = 128, HTB = HALF * BK * 2  , STAGE_BYTES = 8 * HTB, NXCD = 8, WGM = 8;

__host__ __device__ __forceinline__ int lds_byte(int r, int c) { const int st = (r >> 4) * 2 + (c >> 5), rr = r & 15, cc = c & 31, ob = rr * 64 + cc * 2; return st * 1024 + (ob ^ (((ob >> 9) & 1) << 5)); }
__host__ __device__ __forceinline__ void stage_rc(int b, int& R, int& C) { const int st = b / 1024, sb = b % 1024, swz = sb ^ (((sb >> 9) & 1) << 5); R = (st >> 1) * 16 + swz / 64; C = (st & 1) * 32 + (swz % 64) / 2; }
__host__ __device__ __forceinline__ int perm32(int rho) { const int n = rho >> 4, i = rho & 15; return 8 * (i >> 2) + 4 * n + (i & 3); }

struct Unit { int pm, pn; };
struct Gemm { const bf16_t* A; const bf16_t* Bt; int M, N, K; };

struct StaticOrder {
    int nM, nN, nwg, G, c;
    __host__ __device__ void init(int M, int N, int G_, int c_) { nM = M / BM; nN = N / BM; nwg = nM * nN; G = G_; c = c_; }
    __host__ __device__ bool next(int i, Unit& u) const {
        const long L = (long)i * G + c; if (L >= nwg) return false;
        int wgid = (int)L; { const int q = nwg / NXCD, r = nwg % NXCD, xcd = wgid % NXCD, off = wgid / NXCD; wgid = (xcd < r ? xcd * (q + 1) : r * (q + 1) + (xcd - r) * q) + off; }
        const int nig = WGM * nN, gid = wgid / nig, fm = gid * WGM, gsz = (nM - fm) < WGM ? (nM - fm) : WGM;
        u.pm = fm + ((wgid % nig) % gsz); u.pn = (wgid % nig) / gsz; return true;
    }
    __device__ __forceinline__ void a_ready(const Unit&) const {}
    __device__ __forceinline__ void done(const Unit&) const {}
};

__device__ __forceinline__ unsigned cvt_pk_bf16(float lo, float hi) { unsigned r; asm volatile("v_cvt_pk_bf16_f32 %0, %1, %2" : "=v"(r) : "v"(lo), "v"(hi)); return r; }
typedef float f32x2 __attribute__((ext_vector_type(2)));
constexpr float QK_C2 = 0.125f * 1.4426950408889634f;
constexpr int PROJ_LD = 7680, DMODEL = 2048;
__device__ __forceinline__ float silu_f(float v) { return v * __builtin_amdgcn_rcpf(1.0f + __builtin_amdgcn_exp2f(-1.4426950408889634f * v)); }
struct EpiProj {
    static constexpr bool PERM = true, AFTER_DRAIN = false;
    bf16_t* O; const float* ssq; const float* rope;
    __device__ __forceinline__ void operator()(const f32x4 (&acc)[2][2][4][2], const Unit& u, int wr, int wc, int fr, int fq) const {
        const int row0 = u.pm * BM + wr * 64 + fr, col0 = u.pn * BM + wc * 32 + 8 * fq, pn = u.pn;
        const int mode = (pn < 8) ? 1 : (((pn >= 12 && pn < 16) || pn == 20 || pn == 21 || pn >= 28) ? 2 : 0);
        const float qs = (pn < 4) ? QK_C2 : 1.0f;
        const int g4 = 4 * (4 * (wc & 1) + fq);
#pragma unroll
        for (int ai = 0; ai < 2; ++ai)
#pragma unroll
            for (int m = 0; m < 4; ++m) {
                const int row = row0 + ai * HALF + m * 16;
                const float rs = __builtin_amdgcn_rsqf(ssq[row] * (1.0f / 2048.0f) + 1e-5f);
                bf16_t* rowp = O + (size_t)row * PROJ_LD + col0;
                if (mode == 1) {
                    const float* rp = rope + (size_t)(row & 4095) * 64 + g4;
                    const f32x4 c4 = *(const f32x4*)rp, s4 = *(const f32x4*)(rp + 32);
                    const float sc = rs * qs;
#pragma unroll
                    for (int bj = 0; bj < 2; ++bj) { const f32x4 v0 = acc[ai][bj][m][0] * sc, v1 = acc[ai][bj][m][1] * sc;
                        const f32x4 o0 = v0 * c4 - v1 * s4, o1 = v1 * c4 + v0 * s4;
                        u32x4 w; w.x = cvt_pk_bf16(o0[0], o0[1]); w.y = cvt_pk_bf16(o0[2], o0[3]); w.z = cvt_pk_bf16(o1[0], o1[1]); w.w = cvt_pk_bf16(o1[2], o1[3]);
                        *(u32x4*)(rowp + bj * HALF) = w; }
                } else if (mode == 2) {
#pragma unroll
                    for (int bj = 0; bj < 2; ++bj) { f32x4 v0 = acc[ai][bj][m][0] * rs, v1 = acc[ai][bj][m][1] * rs;
#pragma unroll
                        for (int j = 0; j < 4; ++j) { v0[j] = silu_f(v0[j]); v1[j] = silu_f(v1[j]); }
                        u32x4 w; w.x = cvt_pk_bf16(v0[0], v0[1]); w.y = cvt_pk_bf16(v0[2], v0[3]); w.z = cvt_pk_bf16(v1[0], v1[1]); w.w = cvt_pk_bf16(v1[2], v1[3]);
                        *(u32x4*)(rowp + bj * HALF) = w; }
                } else {
#pragma unroll
                    for (int bj = 0; bj < 2; ++bj) { const f32x4 v0 = acc[ai][bj][m][0] * rs, v1 = acc[ai][bj][m][1] * rs;
                        u32x4 w; w.x = cvt_pk_bf16(v0[0], v0[1]); w.y = cvt_pk_bf16(v0[2], v0[3]); w.z = cvt_pk_bf16(v1[0], v1[1]); w.w = cvt_pk_bf16(v1[2], v1[3]);
                        *(u32x4*)(rowp + bj * HALF) = w; }
                }
            }
    }
};
struct EpiResid {
    static constexpr bool PERM = true, AFTER_DRAIN = false;
    const float* base32; const bf16_t* base16; bf16_t* xb; float* ssq;
    __device__ __forceinline__ void operator()(const f32x4 (&acc)[2][2][4][2], const Unit& u, int wr, int wc, int fr, int fq) const {
        const int row0 = u.pm * BM + wr * 64 + fr, col0 = u.pn * BM + wc * 32 + 8 * fq;
#pragma unroll
        for (int ai = 0; ai < 2; ++ai)
#pragma unroll
            for (int m = 0; m < 4; ++m) {
                const int row = row0 + ai * HALF + m * 16; const size_t off = (size_t)row * DMODEL + col0;
                f32x4 b[2][2];
                if (base32) {
#pragma unroll
                    for (int bj = 0; bj < 2; ++bj) { b[bj][0] = *(const f32x4*)(base32 + off + bj * HALF); b[bj][1] = *(const f32x4*)(base32 + off + bj * HALF + 4); }
                } else {
#pragma unroll
                    for (int bj = 0; bj < 2; ++bj) { const u32x4 w = *(const u32x4*)(base16 + off + bj * HALF);
                        b[bj][0] = (f32x4){__uint_as_float(w.x << 16), __uint_as_float(w.x & 0xffff0000u), __uint_as_float(w.y << 16), __uint_as_float(w.y & 0xffff0000u)};
                        b[bj][1] = (f32x4){__uint_as_float(w.z << 16), __uint_as_float(w.z & 0xffff0000u), __uint_as_float(w.w << 16), __uint_as_float(w.w & 0xffff0000u)}; }
                }
                float part = 0.f;
#pragma unroll
                for (int bj = 0; bj < 2; ++bj) { const f32x4 x0 = b[bj][0] + acc[ai][bj][m][0], x1 = b[bj][1] + acc[ai][bj][m][1];
                    u32x4 w; w.x = cvt_pk_bf16(x0[0], x0[1]); w.y = cvt_pk_bf16(x0[2], x0[3]); w.z = cvt_pk_bf16(x1[0], x1[1]); w.w = cvt_pk_bf16(x1[2], x1[3]); *(u32x4*)(xb + off + bj * HALF) = w;
                    part += (x0[0] * x0[0] + x0[1] * x0[1]) + (x0[2] * x0[2] + x0[3] * x0[3]) + (x1[0] * x1[0] + x1[1] * x1[1]) + (x1[2] * x1[2] + x1[3] * x1[3]); }
                if (ssq) { part += __shfl_xor(part, 16); part += __shfl_xor(part, 32); if (fq == 0) atomicAdd(ssq + row, part); }
            }
    }
};


template <class Epi, class Sched, bool ALIGN_EPI = false, bool SP2 = false>
__device__ __forceinline__ void gemm_phase(PG8_LAS unsigned char* lds, const Gemm g, const Sched& S, const Epi& E) {
    int tid_ = threadIdx.x; asm volatile("" : "+v"(tid_));
    const int tid = tid_, wid = __builtin_amdgcn_readfirstlane(tid >> 6), lane = tid & 63, wr = wid >> 2, wc = wid & 3, fr = lane & 15, fq = lane >> 4;
    const int K = g.K, nt = K / BK;
    unsigned voffA[2], voffB[2];
#pragma unroll
    for (int i = 0; i < 2; ++i) { int R, C; stage_rc(tid * 16 + i * 8192, R, C); const int Rb = Epi::PERM ? ((R & ~31) + perm32(R & 31)) : R;
        voffA[i] = (unsigned)(R * K + C) * 2u; voffB[i] = (unsigned)(Rb * K + C) * 2u; }
    const size_t kstep = (size_t)(BK * 2);
    const size_t hstep = (size_t)HALF * K * 2;
    const size_t tstep = 2 * hstep;
    const unsigned ldsw = (unsigned)wid * 1024u;
    const int aoff = lds_byte(wr * 64 + fr, fq * 8), boff = lds_byte(wc * 32 + fr, fq * 8);
#define PG8_SA(b, h) (((b) * 2 + (h)) * HTB)
#define PG8_SB(b, h) ((4 + (b) * 2 + (h)) * HTB)
#define PG8_STAGE(bufoff, gbase, voff) do { _Pragma("unroll") for (int _i = 0; _i < 2; ++_i) \
        __builtin_amdgcn_global_load_lds((const unsigned*)((const char*)(gbase) + (voff)[_i]), (PG8_LAS unsigned*)(lds + (bufoff) + ldsw + _i * 8192), 16, 0, 0); } while (0)
#define PG8_LDA(dst, b, h) do { _Pragma("unroll") for (int m = 0; m < 4; ++m) _Pragma("unroll") for (int k = 0; k < 2; ++k) dst[m][k] = *(const PG8_LAS bf16x8*)(lds + PG8_SA(b, h) + aoff + m * 2048 + k * 1024); } while (0)
#define PG8_LDB(dst, b, h) do { _Pragma("unroll") for (int n = 0; n < 2; ++n) _Pragma("unroll") for (int k = 0; k < 2; ++k) dst[n][k] = *(const PG8_LAS bf16x8*)(lds + PG8_SB(b, h) + boff + n * 2048 + k * 1024); } while (0)
#define PG8_MMA(ai, bj, At, Bt) do { __builtin_amdgcn_s_setprio(1); _Pragma("unroll") for (int m = 0; m < 4; ++m) _Pragma("unroll") for (int n = 0; n < 2; ++n) _Pragma("unroll") for (int k = 0; k < 2; ++k) \
        acc[ai][bj][m][n] = __builtin_amdgcn_mfma_f32_16x16x32_bf16(Bt[n][k], At[m][k], acc[ai][bj][m][n], 0, 0, 0); __builtin_amdgcn_s_setprio(0); } while (0)
#define PG8_WAIT_V(n) asm volatile("s_waitcnt vmcnt(" #n ")" ::: "memory")
#define PG8_WAIT_L(n) asm volatile("s_waitcnt lgkmcnt(" #n ")" ::: "memory")
#define PG8_BAR __builtin_amdgcn_s_barrier()
#define PG8_SCHED __builtin_amdgcn_sched_barrier(0)
    Unit cur, nxt; int ui = 0;
    if (!S.next(0, cur)) return;
    f32x4 acc[2][2][4][2];
#pragma unroll
    for (int a = 0; a < 2; ++a)
#pragma unroll
        for (int b = 0; b < 2; ++b)
#pragma unroll
            for (int m = 0; m < 4; ++m)
#pragma unroll
                for (int n = 0; n < 2; ++n) acc[a][b][m][n] = (f32x4){0.f, 0.f, 0.f, 0.f};
    bf16x8 At[4][2], B0[2][2], B1[2][2];
    const char* cA = (const char*)g.A + (size_t)cur.pm * tstep; const char* cB = (const char*)g.Bt + (size_t)cur.pn * tstep;
    S.a_ready(cur);
    if constexpr (SP2) {
        PG8_STAGE(PG8_SB(0, 0), cB, voffB); PG8_STAGE(PG8_SB(0, 1), cB + hstep, voffB); PG8_STAGE(PG8_SA(0, 0), cA, voffA); PG8_STAGE(PG8_SA(0, 1), cA + hstep, voffA);
        if (wr == 1) PG8_BAR;
        PG8_WAIT_V(2); PG8_BAR;
        PG8_STAGE(PG8_SB(1, 0), cB + kstep, voffB); PG8_STAGE(PG8_SA(1, 0), cA + kstep, voffA); PG8_STAGE(PG8_SB(1, 1), cB + hstep + kstep, voffB);
        PG8_WAIT_V(6); PG8_BAR;
    } else {
        PG8_STAGE(PG8_SB(0, 0), cB, voffB); PG8_STAGE(PG8_SA(0, 0), cA, voffA); PG8_STAGE(PG8_SB(0, 1), cB + hstep, voffB); PG8_STAGE(PG8_SA(0, 1), cA + hstep, voffA);
        if (wr == 1) PG8_BAR;
        PG8_WAIT_V(4); PG8_BAR;
        PG8_STAGE(PG8_SB(1, 0), cB + kstep, voffB); PG8_STAGE(PG8_SA(1, 0), cA + kstep, voffA); PG8_STAGE(PG8_SB(1, 1), cB + hstep + kstep, voffB);
        PG8_WAIT_V(6); PG8_BAR;
    }
    for (;;) {
        const bool has_next = S.next(ui + 1, nxt);
        const char* nA = has_next ? (const char*)g.A + (size_t)nxt.pm * tstep : cA; const char* nB = has_next ? (const char*)g.Bt + (size_t)nxt.pn * tstep : cB;
        for (int t = 0; t < nt; t += 2) {
            const bool last = (t == nt - 2);
            const char* a1 = cA + (size_t)(t + 1) * kstep;
            const char* a2 = last ? nA : cA + (size_t)(t + 2) * kstep; const char* b2 = last ? nB : cB + (size_t)(t + 2) * kstep;
            const char* a3 = a2 + kstep; const char* b3 = b2 + kstep;
            if (last && has_next) S.a_ready(nxt);
            if constexpr (SP2) {
            PG8_LDB(B0, 0, 0); PG8_LDB(B1, 0, 1); PG8_SCHED; PG8_LDA(At, 0, 0); PG8_STAGE(PG8_SA(1, 1), a1 + hstep, voffA);
            PG8_WAIT_V(8); PG8_WAIT_L(0); PG8_BAR; PG8_MMA(0, 0, At, B0); PG8_MMA(0, 1, At, B1); PG8_BAR; PG8_SCHED;
            PG8_LDA(At, 0, 1); PG8_STAGE(PG8_SB(0, 0), b2, voffB); PG8_STAGE(PG8_SB(0, 1), b2 + hstep, voffB); PG8_STAGE(PG8_SA(0, 0), a2, voffA);
            PG8_WAIT_V(8); PG8_WAIT_L(0); PG8_BAR; PG8_MMA(1, 0, At, B0); PG8_MMA(1, 1, At, B1); PG8_BAR; PG8_SCHED;
            PG8_LDB(B0, 1, 0); PG8_LDB(B1, 1, 1); PG8_SCHED; PG8_LDA(At, 1, 0); PG8_STAGE(PG8_SA(0, 1), a2 + hstep, voffA);
            PG8_WAIT_V(8); PG8_WAIT_L(0); PG8_BAR; PG8_MMA(0, 0, At, B0); PG8_MMA(0, 1, At, B1); PG8_BAR; PG8_SCHED;
            PG8_LDA(At, 1, 1); PG8_STAGE(PG8_SB(1, 0), b3, voffB); PG8_STAGE(PG8_SB(1, 1), b3 + hstep, voffB); PG8_STAGE(PG8_SA(1, 0), a3, voffA);
            PG8_WAIT_V(8); PG8_WAIT_L(0); PG8_BAR; PG8_MMA(1, 0, At, B0); PG8_MMA(1, 1, At, B1); PG8_BAR; PG8_SCHED;
            } else {
            PG8_LDB(B0, 0, 0); PG8_SCHED; PG8_LDA(At, 0, 0); PG8_STAGE(PG8_SA(1, 1), a1 + hstep, voffA);
            PG8_WAIT_L(8); PG8_BAR; PG8_WAIT_L(0); PG8_MMA(0, 0, At, B0); PG8_BAR; PG8_SCHED;
            PG8_LDB(B1, 0, 1); PG8_STAGE(PG8_SB(0, 0), b2, voffB);
            PG8_BAR; PG8_WAIT_L(0); PG8_MMA(0, 1, At, B1); PG8_BAR;
            PG8_LDA(At, 0, 1); PG8_STAGE(PG8_SA(0, 0), a2, voffA);
            PG8_BAR; PG8_WAIT_L(0); PG8_MMA(1, 0, At, B0); PG8_BAR; PG8_SCHED;
            PG8_STAGE(PG8_SB(0, 1), b2 + hstep, voffB);
            PG8_WAIT_V(6); PG8_BAR; PG8_MMA(1, 1, At, B1); PG8_BAR;
            PG8_LDB(B0, 1, 0); PG8_SCHED; PG8_LDA(At, 1, 0); PG8_STAGE(PG8_SA(0, 1), a2 + hstep, voffA);
            PG8_WAIT_L(8); PG8_BAR; PG8_WAIT_L(0); PG8_MMA(0, 0, At, B0); PG8_BAR; PG8_SCHED;
            PG8_LDB(B1, 1, 1); PG8_STAGE(PG8_SB(1, 0), b3, voffB);
            PG8_BAR; PG8_WAIT_L(0); PG8_MMA(0, 1, At, B1); PG8_BAR;
            PG8_LDA(At, 1, 1); PG8_STAGE(PG8_SA(1, 0), a3, voffA);
            PG8_BAR; PG8_WAIT_L(0); PG8_MMA(1, 0, At, B0); PG8_BAR; PG8_SCHED;
            PG8_STAGE(PG8_SB(1, 1), b3 + hstep, voffB);
            PG8_WAIT_V(6); PG8_BAR; PG8_MMA(1, 1, At, B1); PG8_BAR;
            }
        }
        if constexpr (ALIGN_EPI) { if (wr == 0) PG8_BAR; }
        if constexpr (!Epi::AFTER_DRAIN) { E(acc, cur, wr, wc, fr, fq); S.done(cur); }
        if (!has_next) break;
#pragma unroll
        for (int a = 0; a < 2; ++a)
#pragma unroll
            for (int b = 0; b < 2; ++b)
#pragma unroll
                for (int m = 0; m < 4; ++m)
#pragma unroll
                    for (int n = 0; n < 2; ++n) acc[a][b][m][n] = (f32x4){0.f, 0.f, 0.f, 0.f};
        cur = nxt; cA = nA; cB = nB; ++ui;
        if constexpr (ALIGN_EPI) { if (wr == 1) PG8_BAR; }
    }
    PG8_WAIT_V(0);
    if constexpr (!ALIGN_EPI) { if (wr == 0) PG8_BAR; }
    PG8_BAR;
    if constexpr (Epi::AFTER_DRAIN) { E.fused(acc, cur, wr, wc, fr, fq, lds, wid, lane); S.done(cur); }
#undef PG8_SA
#undef PG8_SB
#undef PG8_STAGE
#undef PG8_LDA
#undef PG8_LDB
#undef PG8_MMA
#undef PG8_WAIT_V
#undef PG8_WAIT_L
#undef PG8_BAR
#undef PG8_SCHED
}
}
#ifndef PG8_SP2
#define PG8_SP2 true
#endif
#ifndef PG8_ALIGN
#define PG8_ALIGN true
#endif
#include <hip/hip_bf16.h>
#include <cmath>
namespace attn_body {
using bf16=__hip_bfloat16;
using bf16x8=__attribute__((ext_vector_type(8)))short;
using s16x4=__attribute__((ext_vector_type(4)))short;
using f32x16=__attribute__((ext_vector_type(16)))float;
using u32x4=__attribute__((ext_vector_type(4)))unsigned;
constexpr int BATCH=4,NHEAD=8,SEQ=4096,D=64,PQ=7680,PO=2048;
constexpr int NW=8,QBLK=32,QB=QBLK*NW,KVBLK=64,NQB=SEQ/QB;
constexpr int ATTN_UNIT_ROWS=QB;
__device__ __forceinline__ int crow(int r,int hi){return (r&3)+8*(r>>2)+4*hi;}
#define SBAR() __builtin_amdgcn_sched_barrier(0)
__device__ __forceinline__ void cmask(f32x16&p0,f32x16&p1,int jb,int qrel,int hi){
  const float NEG=-INFINITY; int kb=64*jb+4*hi;
  #pragma unroll
  for(int r=0;r<16;++r){int kv=kb+(r&3)+8*(r>>2); if(kv>qrel)p0[r]=NEG; if(kv+32>qrel)p1[r]=NEG;}
}

constexpr int NSLOT=3, SLOTB=8192;
constexpr int LDS_K=0, LDS_V=NSLOT*SLOTB, LDS_WS=2*NSLOT*SLOTB, LDS_OST=LDS_WS+NW*64*4, LDS_BYTES=LDS_OST+NW*4096;
constexpr float C2=0.125f*1.4426950408889634f;
__device__ __forceinline__ void glds16(const void*gsrc,unsigned lds_dst){unsigned keep;
  asm volatile("s_mov_b32 %0, m0\n\ts_mov_b32 m0, %2\n\ts_nop 0\n\tglobal_load_lds_dwordx4 %1, off\n\ts_mov_b32 m0, %0":"=&s"(keep):"v"(gsrc),"s"(lds_dst):"memory");}
__device__ __forceinline__ float max3f(float a,float b,float c){float r;asm("v_max3_f32 %0, %1, %2, %3":"=v"(r):"v"(a),"v"(b),"v"(c));return r;}
__device__ __forceinline__ float max2f(float a,float b){float r;asm("v_max_f32_e32 %0, %1, %2":"=v"(r):"v"(a),"v"(b));return r;}
__device__ __forceinline__ float fadd_s(float a,float b){float r;asm("v_add_f32_e32 %0, %1, %2":"=v"(r):"v"(a),"v"(b));return r;}
__device__ __forceinline__ float fsub_s(float a,float b){float r;asm("v_sub_f32_e32 %0, %1, %2":"=v"(r):"v"(a),"v"(b));return r;}
typedef float f32x2_t __attribute__((ext_vector_type(2))); typedef __bf16 bf16x2_t __attribute__((ext_vector_type(2)));
__device__ __forceinline__ unsigned cvtpk_s(float lo,float hi){f32x2_t v={lo,hi};bf16x2_t b=__builtin_convertvector(v,bf16x2_t);return __builtin_bit_cast(unsigned,b);}
#define WAIT_BAR(N) asm volatile("s_waitcnt vmcnt(" #N ") lgkmcnt(0)\n\ts_barrier":::"memory")

__device__ __forceinline__ void qkt(f32x16&p0,f32x16&p1,const char*Kslot,const bf16x8*qr,const f32x16&negm,int r32,int hi){
  const char*kb=Kslot+hi*1024+r32*16;
  #pragma unroll
  for(int d0=0;d0<4;++d0){
    const bf16x8 b0=*reinterpret_cast<const bf16x8*>(kb+d0*2048);
    const bf16x8 b1=*reinterpret_cast<const bf16x8*>(kb+d0*2048+512);
    if(d0==0){p0=__builtin_amdgcn_mfma_f32_32x32x16_bf16(b0,qr[0],negm,0,0,0);p1=__builtin_amdgcn_mfma_f32_32x32x16_bf16(b1,qr[0],negm,0,0,0);}
    else{p0=__builtin_amdgcn_mfma_f32_32x32x16_bf16(b0,qr[d0],p0,0,0,0);p1=__builtin_amdgcn_mfma_f32_32x32x16_bf16(b1,qr[d0],p1,0,0,0);}}
}
typedef __attribute__((address_space(3))) const char* lds_cptr;
typedef short v4i16_t __attribute__((ext_vector_type(4)));
__device__ __forceinline__ void kload8(bf16x8*kf,lds_cptr kp){
  kf[0]=*(const __attribute__((address_space(3))) bf16x8*)(kp);      kf[1]=*(const __attribute__((address_space(3))) bf16x8*)(kp+512);
  kf[2]=*(const __attribute__((address_space(3))) bf16x8*)(kp+2048); kf[3]=*(const __attribute__((address_space(3))) bf16x8*)(kp+2560);
  kf[4]=*(const __attribute__((address_space(3))) bf16x8*)(kp+4096); kf[5]=*(const __attribute__((address_space(3))) bf16x8*)(kp+4608);
  kf[6]=*(const __attribute__((address_space(3))) bf16x8*)(kp+6144); kf[7]=*(const __attribute__((address_space(3))) bf16x8*)(kp+6656);
}
__device__ __forceinline__ void kload2(bf16x8*kf,lds_cptr kp,int j){ kf[2*j]=*(const __attribute__((address_space(3))) bf16x8*)(kp+j*2048); kf[2*j+1]=*(const __attribute__((address_space(3))) bf16x8*)(kp+j*2048+512); }
__device__ __forceinline__ s16x4 vtr(lds_cptr p){ return __builtin_bit_cast(s16x4,__builtin_amdgcn_ds_read_tr16_b64_v4i16((__attribute__((address_space(3))) v4i16_t*)p)); }
__device__ __forceinline__ float rowmax(const f32x16&p0,const f32x16&p1){
  float a=max3f(p0[0],p0[1],p1[0]),b=max3f(p0[2],p0[3],p1[1]);a=max3f(a,p1[2],p1[3]);
  #pragma unroll
  for(int r=4;r<16;r+=4){a=max3f(a,p0[r],p0[r+1]);b=max3f(b,p0[r+2],p0[r+3]);a=max3f(a,p1[r],p1[r+1]);b=max3f(b,p1[r+2],p1[r+3]);}
  const float m=max2f(a,b);
  auto rr=__builtin_amdgcn_permlane32_swap(__float_as_uint(m),__float_as_uint(m),false,false);
  return max2f(__uint_as_float(rr[0]),__uint_as_float(rr[1]));
}
__device__ __forceinline__ void pv(f32x16*o,int vb,bf16x8 pa0,bf16x8 pa1,bf16x8 pa2,bf16x8 pa3){
  #pragma unroll
  for(int d0=0;d0<2;++d0){s16x4 lo[4],hi[4];
    #pragma unroll
    for(int ks=0;ks<4;++ks){
      asm volatile("ds_read_b64_tr_b16 %0,%1 offset:%c2":"=&v"(lo[ks]):"v"(vb),"i"(d0*4096+ks*1024):"memory");
      asm volatile("ds_read_b64_tr_b16 %0,%1 offset:%c2":"=&v"(hi[ks]):"v"(vb),"i"(d0*4096+ks*1024+512):"memory");}
    asm volatile("s_waitcnt lgkmcnt(0)":::"memory");SBAR();
    #define PK(k) (bf16x8){lo[k][0],lo[k][1],lo[k][2],lo[k][3],hi[k][0],hi[k][1],hi[k][2],hi[k][3]}
    o[d0]=__builtin_amdgcn_mfma_f32_32x32x16_bf16(pa0,PK(0),o[d0],0,0,0);
    o[d0]=__builtin_amdgcn_mfma_f32_32x32x16_bf16(pa1,PK(1),o[d0],0,0,0);
    o[d0]=__builtin_amdgcn_mfma_f32_32x32x16_bf16(pa2,PK(2),o[d0],0,0,0);
    o[d0]=__builtin_amdgcn_mfma_f32_32x32x16_bf16(pa3,PK(3),o[d0],0,0,0);
    #undef PK
  }
}

#ifndef ATTN_STORE16
#define ATTN_STORE16(p,v) (*(u32x4*)(p)=(v))
#endif
template<int THRL> __device__ __forceinline__ void attn_unit(int b,int h,int qb,const bf16*Q,const bf16*__restrict__ K,const bf16*__restrict__ V,bf16*O,char*shm){
  int tid_=threadIdx.x; asm volatile("":"+v"(tid_)); const int tid=tid_,lane=tid&63,r32=lane&31,hi=lane>>5; const int wid=__builtin_amdgcn_readfirstlane(tid>>6);
  const long rowbase=(long)b*SEQ; const int q0=qb*QB;
  const bf16*Qw=Q+(rowbase+q0+wid*QBLK)*PQ;
  const bf16*Kh=K+rowbase*PQ,*Vh=V+rowbase*PQ;
  const unsigned lds0=(unsigned)(uintptr_t)shm;
  float*wsf=(float*)(shm+LDS_WS)+wid*64;
  const bf16*ksrc=Kh+(long)lane*PQ+wid*8;
  const bf16*vsrc=Vh+(long)(16*(wid&3)+(lane>>2))*PQ+(wid>>2)*32+(lane&3)*8;
  const unsigned kdst=lds0+LDS_K+wid*1024, vdst=lds0+LDS_V+wid*1024;
  #define DMA_K(t,slot) glds16(ksrc+(long)(t)*KVBLK*PQ,(unsigned)__builtin_amdgcn_readfirstlane(kdst+(slot)))
  #define DMA_V(t,slot) glds16(vsrc+(long)(t)*KVBLK*PQ,(unsigned)__builtin_amdgcn_readfirstlane(vdst+(slot)))
  const int vb0=(int)(lds0+LDS_V)+((lane>>4)&1)*32+(lane&3)*8+(4*hi+((lane&15)>>2))*64;
  const char*Kbase=shm+LDS_K; bf16x8 kf[8];
  const lds_cptr shm3=(lds_cptr)shm; const lds_cptr kp0=shm3+LDS_K+hi*1024+r32*16; const lds_cptr vp0=shm3+LDS_V+((lane>>4)&1)*32+(lane&3)*8+(4*hi+((lane&15)>>2))*64;
  const int NT=(q0+QB)/KVBLK;
  DMA_K(0,0);DMA_V(0,0);DMA_K(1,SLOTB);
  bf16x8 qr[4];
  #pragma unroll
  for(int d0=0;d0<4;++d0)qr[d0]=*reinterpret_cast<const bf16x8*>(&Qw[(long)r32*PQ+d0*16+hi*8]);
  float mhat=0.f,l_reg=0.f;f32x16 o[2];o[0]=f32x16{};o[1]=f32x16{};f32x16 negm=f32x16{};asm volatile("":"+v"(negm));
  const int qrel=wid*QBLK+r32;
  #define CMASK(P0,P1,t) do{int jb_=(t)-(NT-4); if(jb_>=0)cmask(P0,P1,jb_,qrel,hi);}while(0)
  bool resc=false;
  #define START(P0,P1) do{ const float rm=rowmax(P0,P1); resc=false; \
    { const float dl=rm; mhat=fadd_s(mhat,dl); \
      _Pragma("unroll") for(int r=0;r<16;++r){P0[r]=fsub_s(P0[r],dl);P1[r]=fsub_s(P1[r],dl);} \
      _Pragma("unroll") for(int r=0;r<16;++r)negm[r]=-mhat; asm volatile("":"+v"(negm)); } \
    _Pragma("unroll") for(int r=0;r<16;++r)P0[r]=__builtin_amdgcn_exp2f(P0[r]); }while(0)
  #define RESC() do{ if(resc){ asm volatile("s_waitcnt lgkmcnt(0)":::"memory"); \
      _Pragma("unroll") for(int d_=0;d_<2;++d_) _Pragma("unroll") for(int r=0;r<16;++r)o[d_][r]*=wsf[crow(r,hi)]; } }while(0)
  f32x16 pA0,pA1,pB0,pB1;
  int sl_prev=0,sl_cur=0,sl_next=SLOTB;
  #define ROT() do{sl_prev=sl_cur;sl_cur=sl_next;sl_next=(sl_next==(NSLOT-1)*SLOTB)?0:sl_next+SLOTB;}while(0)
  DMA_K(2,2*SLOTB);
  WAIT_BAR(3);
  qkt(pA0,pA1,Kbase,qr,negm,r32,hi);asm volatile("s_nop 15\n\ts_nop 7":"+v"(pA0),"+v"(pA1));CMASK(pA0,pA1,0);
  START(pA0,pA1);
  _Pragma("unroll") for(int r=0;r<16;++r)pA1[r]=__builtin_amdgcn_exp2f(pA1[r]);
  WAIT_BAR(0);
  DMA_K(3,0);DMA_V(1,SLOTB);
  ROT();
  kload8(kf,kp0+sl_cur);
  WAIT_BAR(2);
  s16x4 vlo[8],vhi[8]; u32x4 pw0,pw1,pw2,pw3;
  #define PKW(P,B) cvtpk_s(P[B],P[B+1])
  #define PAF(k) __builtin_bit_cast(bf16x8,pw##k)
  #define VFR(i) (bf16x8){vlo[i][0],vlo[i][1],vlo[i][2],vlo[i][3],vhi[i][0],vhi[i][1],vhi[i][2],vhi[i][3]}
  #define PIN(x) asm volatile("":"+v"(x))
  #define MX3(a,b,c) __builtin_fmaxf(__builtin_fmaxf((a),(b)),(c))
  #define GAPA(MF,A0,A1,A2,A3,W0,W1,PW) do{ MF; sacc+=A0; sacc+=A1; sacc+=A2; sacc+=A3; PIN(sacc); W0; W1; PIN(PW); SBAR(); }while(0)
  #define EX(v) __builtin_amdgcn_exp2f(v)
  #define GAPB(MF,X,B) do{ MF; X[B]=EX(X[B]); X[B+1]=EX(X[B+1]); X[B+2]=EX(X[B+2]); X[B+3]=EX(X[B+3]); PIN(X); SBAR(); }while(0)
  #define VRD(i) do{ vlo[i]=vtr(vp_+(((i)>>2)*4096+((i)&3)*1024)); vhi[i]=vtr(vp_+(((i)>>2)*4096+((i)&3)*1024+512)); }while(0)
  #define KRD(G,j) do{ if(G){ kload2(kf,kp0+sl_next,j); SBAR(); } }while(0)
  #define STEP(C0,C1,P0,P1,t,GK,GV,GL) do{ SBAR(); \
    const lds_cptr vp_=vp0+sl_prev; \
    VRD(0); SBAR(); float sacc=(P0[0]+P0[1]); \
    GAPA(C0=__builtin_amdgcn_mfma_f32_32x32x16_bf16(kf[0],qr[0],negm,0,0,0), P0[2],P0[3],P0[4],P0[5],     pw0[0]=PKW(P0,0), pw0[1]=PKW(P0,2), pw0); \
    VRD(4); SBAR(); GAPA(C1=__builtin_amdgcn_mfma_f32_32x32x16_bf16(kf[1],qr[0],negm,0,0,0), P0[6],P0[7],P0[8],P0[9],     pw0[2]=PKW(P0,4), pw0[3]=PKW(P0,6), pw0); \
    VRD(1); SBAR(); GAPA(C0=__builtin_amdgcn_mfma_f32_32x32x16_bf16(kf[2],qr[1],C0,0,0,0),   P0[10],P0[11],P0[12],P0[13], pw1[0]=PKW(P0,8), pw1[1]=PKW(P0,10), pw1); \
    VRD(5); SBAR(); GAPA(C1=__builtin_amdgcn_mfma_f32_32x32x16_bf16(kf[3],qr[1],C1,0,0,0),   P0[14],P0[15],P1[0],P1[1],   pw1[2]=PKW(P0,12),pw1[3]=PKW(P0,14), pw1); \
    VRD(2); SBAR(); GAPA(C0=__builtin_amdgcn_mfma_f32_32x32x16_bf16(kf[4],qr[2],C0,0,0,0),   P1[2],P1[3],P1[4],P1[5],     pw2[0]=PKW(P1,0), pw2[1]=PKW(P1,2), pw2); \
    VRD(6); SBAR(); GAPA(C1=__builtin_amdgcn_mfma_f32_32x32x16_bf16(kf[5],qr[2],C1,0,0,0),   P1[6],P1[7],P1[8],P1[9],     pw2[2]=PKW(P1,4), pw2[3]=PKW(P1,6), pw2); \
    VRD(3); SBAR(); GAPA(C0=__builtin_amdgcn_mfma_f32_32x32x16_bf16(kf[6],qr[3],C0,0,0,0),   P1[10],P1[11],P1[12],P1[13], pw3[0]=PKW(P1,8), pw3[1]=PKW(P1,10), pw3); \
    VRD(7); SBAR(); GAPA(C1=__builtin_amdgcn_mfma_f32_32x32x16_bf16(kf[7],qr[3],C1,0,0,0),   P1[14],P1[15],0.f,0.f,       pw3[2]=PKW(P1,12),pw3[3]=PKW(P1,14), pw3); \
    l_reg+=sacc; \
    if(GK){DMA_K((t)+3,sl_cur);} if(GV){DMA_V((t)+1,sl_next);} \
    CMASK(C0,C1,t); \
    { float a=MX3(C0[0],C0[1],C1[0]),b=MX3(C0[2],C0[3],C1[1]); a=MX3(a,C1[2],C1[3]); \
      _Pragma("unroll") for(int r=4;r<16;r+=4){a=MX3(a,C0[r],C0[r+1]);b=MX3(b,C0[r+2],C0[r+3]);a=MX3(a,C1[r],C1[r+1]);b=MX3(b,C1[r+2],C1[r+3]);} \
      float rm=__builtin_fmaxf(a,b); { auto rr=__builtin_amdgcn_permlane32_swap(__float_as_uint(rm),__float_as_uint(rm),false,false); rm=__builtin_fmaxf(__uint_as_float(rr[0]),__uint_as_float(rr[1])); } \
      resc=false; \
      if(__builtin_expect(__any(rm>(float)THRL),0)){ const float dl=__builtin_fmaxf(rm,0.f); mhat+=dl; \
        _Pragma("unroll") for(int r=0;r<16;++r){C0[r]-=dl;C1[r]-=dl;} \
        _Pragma("unroll") for(int r=0;r<16;++r)negm[r]=-mhat; asm volatile("":"+v"(negm)); \
        const float f=__builtin_amdgcn_exp2f(-dl); l_reg*=f; if(hi==0)wsf[r32]=f; resc=true; } } \
    SBAR(); \
    GAPB(o[0]=__builtin_amdgcn_mfma_f32_32x32x16_bf16(PAF(0),VFR(0),o[0],0,0,0), C0,0); \
    GAPB(o[1]=__builtin_amdgcn_mfma_f32_32x32x16_bf16(PAF(0),VFR(4),o[1],0,0,0), C0,4); \
    KRD(GL,0); GAPB(o[0]=__builtin_amdgcn_mfma_f32_32x32x16_bf16(PAF(1),VFR(1),o[0],0,0,0), C0,8); \
    KRD(GL,1); GAPB(o[1]=__builtin_amdgcn_mfma_f32_32x32x16_bf16(PAF(1),VFR(5),o[1],0,0,0), C0,12); \
    KRD(GL,2); GAPB(o[0]=__builtin_amdgcn_mfma_f32_32x32x16_bf16(PAF(2),VFR(2),o[0],0,0,0), C1,0); \
    KRD(GL,3); GAPB(o[1]=__builtin_amdgcn_mfma_f32_32x32x16_bf16(PAF(2),VFR(6),o[1],0,0,0), C1,4); \
    GAPB(o[0]=__builtin_amdgcn_mfma_f32_32x32x16_bf16(PAF(3),VFR(3),o[0],0,0,0), C1,8); \
    GAPB(o[1]=__builtin_amdgcn_mfma_f32_32x32x16_bf16(PAF(3),VFR(7),o[1],0,0,0), C1,12); \
    }while(0)
  int t=1;
  #undef CMASK
  #define CMASK(P0,P1,t) do{}while(0)
  for(;t+5<NT;t+=2){
    STEP(pB0,pB1,pA0,pA1,t,true,true,true);     WAIT_BAR(2); RESC(); ROT();
    STEP(pA0,pA1,pB0,pB1,t+1,true,true,true);   WAIT_BAR(2); RESC(); ROT();
  }
  #undef CMASK
  #define CMASK(P0,P1,t) do{int jb_=(t)-(NT-4); if(jb_>=0)cmask(P0,P1,jb_,qrel,hi);}while(0)
  #define ENDW(tt) do{ if((tt)+3<NT){WAIT_BAR(2);} else if((tt)+2<NT){WAIT_BAR(1);} else {WAIT_BAR(0);} }while(0)
  for(;t+1<NT;t+=2){
    STEP(pB0,pB1,pA0,pA1,t,(t+3<NT),(t+1<NT),(t+1<NT));       ENDW(t);   RESC(); ROT();
    STEP(pA0,pA1,pB0,pB1,t+1,(t+4<NT),(t+2<NT),(t+2<NT));     ENDW(t+1); RESC(); ROT();
  }
  STEP(pB0,pB1,pA0,pA1,NT-1,false,false,false); RESC();
  { float sacc=pB0[0]+pB0[1]; _Pragma("unroll") for(int r=2;r<16;++r)sacc+=pB0[r]; _Pragma("unroll") for(int r=0;r<16;++r)sacc+=pB1[r]; l_reg+=sacc;
    pw0=(u32x4){PKW(pB0,0),PKW(pB0,2),PKW(pB0,4),PKW(pB0,6)};pw1=(u32x4){PKW(pB0,8),PKW(pB0,10),PKW(pB0,12),PKW(pB0,14)};pw2=(u32x4){PKW(pB1,0),PKW(pB1,2),PKW(pB1,4),PKW(pB1,6)};pw3=(u32x4){PKW(pB1,8),PKW(pB1,10),PKW(pB1,12),PKW(pB1,14)};
    SBAR(); pv(o,vb0+sl_cur,PAF(0),PAF(1),PAF(2),PAF(3)); }
  #undef PKW
  #undef PAF
  #undef VFR
  #undef PIN
  #undef MX3
  #undef GAPA
  #undef GAPB
  #undef EX
  #undef VRD
  #undef KRD
  #undef STEP
  #undef ENDW
  {auto rr=__builtin_amdgcn_permlane32_swap(__float_as_uint(l_reg),__float_as_uint(l_reg),false,false);l_reg=__uint_as_float(rr[0])+__uint_as_float(rr[1]);}
  if(hi==0)wsf[32+r32]=l_reg;asm volatile("s_waitcnt lgkmcnt(0)":::"memory");
  float rli[16];
  #pragma unroll
  for(int r=0;r<16;++r)rli[r]=__builtin_amdgcn_rcpf(wsf[32+crow(r,hi)]);
  bf16*Ow=O+(rowbase+q0+wid*QBLK)*PO;
  { bf16*stg=(bf16*)(shm+LDS_OST)+wid*2048;
    #pragma unroll
    for(int r=0;r<16;++r){const int orow=crow(r,hi);
      #pragma unroll
      for(int d0=0;d0<2;++d0)stg[orow*64+d0*32+r32]=__float2bfloat16(o[d0][r]*rli[r]);}
    asm volatile("s_waitcnt lgkmcnt(0)":::"memory");
    #pragma unroll
    for(int i=0;i<4;++i){const int row=i*8+(lane>>3),ch=lane&7; const u32x4 v=*(const u32x4*)(stg+row*64+ch*8); ATTN_STORE16(Ow+(long)row*PO+ch*8,v);} }
  asm volatile("s_waitcnt lgkmcnt(0)\n\ts_barrier":::"memory");
  #undef DMA_K
  #undef DMA_V
  #undef CMASK
  #undef START
  #undef RESC
  #undef ROT
}
constexpr int ATTN_LDS_BYTES=LDS_BYTES;
struct AttnTensors { const bf16* P; bf16* O; };
struct AttnUnit { int b, h, c, vh, qb; };
struct StaticOrder {
  int vcu;
  __device__ __forceinline__ explicit StaticOrder(int vcu_):vcu(vcu_){}
  __device__ __forceinline__ bool next(int i,AttnUnit&u)const{ if(i>=8||vcu>=BATCH*NHEAD*8)return false; const int v=vcu,sub=i&7,s=v&7,bh=v>>3;
    u.b=bh>>3; u.h=bh&7; u.qb=(sub<4)?(NQB-1-s):s; u.c=(sub>>1)&1; u.vh=sub&1; return true; }
  __device__ __forceinline__ void a_ready(const AttnUnit&)const{}
  __device__ __forceinline__ void done(const AttnUnit&)const{}
};
template<class Sched,int THRL=8> __device__ __forceinline__ void attn_phase(char*lds,const AttnTensors&T,const Sched&S){
  AttnUnit u;
  for(int i=0;S.next(i,u);++i){ S.a_ready(u);
    attn_unit<THRL>(u.b,0,u.qb,T.P+u.h*128+u.c*64,T.P+1024+u.h*128+u.c*64,T.P+2048+u.h*128+u.vh*64,T.O+u.c*1024+u.h*128+u.vh*64,lds); S.done(u); }
}
#undef SBAR
#undef WAIT_BAR
}
namespace attn2 {
typedef unsigned short bf16;
typedef short bf16x8 __attribute__((ext_vector_type(8)));
typedef short s16x4 __attribute__((ext_vector_type(4)));
typedef float f32x16 __attribute__((ext_vector_type(16)));
typedef float f32x4 __attribute__((ext_vector_type(4)));
typedef unsigned u32x4 __attribute__((ext_vector_type(4)));
constexpr int NW = 8, QBLK = 32, KVBLK = 64, QB = NW * QBLK, DQ = 64, DV = 128, PQ = 7680, PO = 2048, SEQ = 4096, NQB = SEQ / QB;
constexpr int SHM_V = KVBLK * DV * 2, SHM_K = KVBLK * DQ * 2;
constexpr int LDS_WS = 2 * SHM_V + 2 * SHM_K, LDS_OST = LDS_WS + NW * 64 * 4, LDS_BYTES = LDS_OST + NW * QBLK * DV * 2;
constexpr float THR = 8.f;
#define A2_KSWZ(row, colB) ((row) * 128 + ((colB) ^ ((((row) >> 1) & 7) << 4)))
#define A2_SBAR() __builtin_amdgcn_sched_barrier(0)
__device__ __forceinline__ int v_st(int k, int c) { const int kk = (k & ~0xC) | ((k & 4) << 1) | ((k & 8) >> 1); return ((kk >> 3) * 4 + (c >> 5)) * 512 + ((kk & 7) * 32 + (c & 31)) * 2; }
__device__ __forceinline__ int v_rd_base(int lane) { return ((lane & 3) << 3) | (((lane >> 2) & 3) << 6) | (((lane >> 4) & 1) << 5) | (((lane >> 5) & 1) << 8); }
constexpr int v_rd_off(int d0, int ks, int half) { return d0 * 512 + ks * 4096 + half * 2048; }
__device__ __forceinline__ int crow(int r, int hi) { return (r & 3) + 8 * (r >> 2) + 4 * hi; }
__device__ __forceinline__ unsigned cvtpk(float lo, float hi) { unsigned r; asm volatile("v_cvt_pk_bf16_f32 %0, %1, %2" : "=v"(r) : "v"(lo), "v"(hi)); return r; }
__device__ __forceinline__ bf16x8 load8(const bf16* p) { return *reinterpret_cast<const bf16x8*>(p); }
__device__ __forceinline__ void mask_tile(f32x16& p0, f32x16& p1, int dq) {
    const float NEG = -__builtin_inff();
#pragma unroll
    for (int r = 0; r < 16; ++r) { const int c = (r & 3) + 8 * (r >> 2); if (dq - c < 0) p0[r] = NEG; if (dq - c - 32 < 0) p1[r] = NEG; }
}
__device__ __forceinline__ void softmax_tile(f32x16& p0, f32x16& p1, float& m_reg, f32x16& negm, float& alpha, float& l_reg, bool first, bf16x8& pa0, bf16x8& pa1, bf16x8& pa2, bf16x8& pa3) {
    float a = fmaxf(fmaxf(p0[0], p0[1]), p1[0]), b = fmaxf(fmaxf(p0[2], p0[3]), p1[1]);
#pragma unroll
    for (int r = 4; r < 16; r += 4) { a = fmaxf(fmaxf(a, p0[r]), p0[r + 1]); b = fmaxf(fmaxf(b, p0[r + 2]), p0[r + 3]); }
#pragma unroll
    for (int r = 2; r < 16; r += 2) { a = fmaxf(a, p1[r]); b = fmaxf(b, p1[r + 1]); }
    float pmax = fmaxf(a, b);
    { auto rr = __builtin_amdgcn_permlane32_swap(__float_as_uint(pmax), __float_as_uint(pmax), false, false); pmax = fmaxf(__uint_as_float(rr[0]), __uint_as_float(rr[1])); }
    alpha = 1.f;
    if (__builtin_expect(first || !__all(pmax <= THR), 0)) {
        const float dl = first ? pmax : fmaxf(pmax, 0.f);
        m_reg += dl; alpha = first ? 1.f : __builtin_amdgcn_exp2f(-dl);
#pragma unroll
        for (int r = 0; r < 16; ++r) { p0[r] -= dl; p1[r] -= dl; negm[r] = -m_reg; }
    }
#pragma unroll
    for (int r = 0; r < 16; ++r) p0[r] = __builtin_amdgcn_exp2f(p0[r]);
#pragma unroll
    for (int r = 0; r < 16; ++r) p1[r] = __builtin_amdgcn_exp2f(p1[r]);
    float s0 = p0[0] + p0[1], s1 = p0[2] + p0[3], s2 = p1[0] + p1[1], s3 = p1[2] + p1[3];
#pragma unroll
    for (int r = 4; r < 16; r += 4) { s0 += p0[r] + p0[r + 1]; s1 += p0[r + 2] + p0[r + 3]; s2 += p1[r] + p1[r + 1]; s3 += p1[r + 2] + p1[r + 3]; }
    float ps = (s0 + s1) + (s2 + s3);
    { auto rr = __builtin_amdgcn_permlane32_swap(__float_as_uint(ps), __float_as_uint(ps), false, false); ps = __uint_as_float(rr[0]) + __uint_as_float(rr[1]); }
    l_reg = l_reg * alpha + ps;
#define A2_PK4(P, B_, OUT) do { unsigned a0 = cvtpk(P[B_+0], P[B_+1]), a1 = cvtpk(P[B_+2], P[B_+3]); unsigned b0 = cvtpk(P[B_+4], P[B_+5]), b1 = cvtpk(P[B_+6], P[B_+7]); \
        auto r0 = __builtin_amdgcn_permlane32_swap(a0, b0, false, false); auto r1 = __builtin_amdgcn_permlane32_swap(a1, b1, false, false); \
        u32x4 w = {r0[0], r1[0], r0[1], r1[1]}; OUT = *reinterpret_cast<bf16x8*>(&w); } while (0)
    A2_PK4(p0, 0, pa0); A2_PK4(p0, 8, pa1); A2_PK4(p1, 0, pa2); A2_PK4(p1, 8, pa3);
#undef A2_PK4
}
template <int KB> __device__ __forceinline__ void kload(bf16x8* kf, const char* K_lds, int r32, int hi) {
#pragma unroll
    for (int d0 = 0; d0 < 4; ++d0) { const char* a = K_lds + KB * SHM_K + A2_KSWZ(r32, (d0 * 16 + hi * 8) * 2);
        kf[2 * d0] = *reinterpret_cast<const bf16x8*>(a); kf[2 * d0 + 1] = *reinterpret_cast<const bf16x8*>(a + 32 * 128); }
}
__device__ __forceinline__ void qkt(f32x16& p0, f32x16& p1, const bf16x8* kf, const bf16x8* qr, const f32x16& negm) {
    p0 = negm; p1 = negm;
#pragma unroll
    for (int d0 = 0; d0 < 4; ++d0) { p0 = __builtin_amdgcn_mfma_f32_32x32x16_bf16(kf[2 * d0], qr[d0], p0, 0, 0, 0); p1 = __builtin_amdgcn_mfma_f32_32x32x16_bf16(kf[2 * d0 + 1], qr[d0], p1, 0, 0, 0); }
}
template <int VB> __device__ __forceinline__ void pv_tile(f32x16* o, int vb0, bf16x8 pa0, bf16x8 pa1, bf16x8 pa2, bf16x8 pa3) {
#define A2_TRRD(dst, off) asm volatile("ds_read_b64_tr_b16 %0, %1 offset:%2" : "=&v"(dst) : "v"(vb0), "i"(off) : "memory")
#define A2_PV_D0(d0) do { s16x4 l0, l1, l2, l3, h0, h1, h2, h3; constexpr int b_ = VB * SHM_V + v_rd_off(d0, 0, 0); \
        A2_TRRD(l0, b_); A2_TRRD(h0, b_ + 2048); A2_TRRD(l1, b_ + 4096); A2_TRRD(h1, b_ + 6144); A2_TRRD(l2, b_ + 8192); A2_TRRD(h2, b_ + 10240); A2_TRRD(l3, b_ + 12288); A2_TRRD(h3, b_ + 14336); \
        asm volatile("s_waitcnt lgkmcnt(0)" ::: "memory"); A2_SBAR(); \
        o[d0] = __builtin_amdgcn_mfma_f32_32x32x16_bf16(pa0, (bf16x8){l0[0], l0[1], l0[2], l0[3], h0[0], h0[1], h0[2], h0[3]}, o[d0], 0, 0, 0); \
        o[d0] = __builtin_amdgcn_mfma_f32_32x32x16_bf16(pa1, (bf16x8){l1[0], l1[1], l1[2], l1[3], h1[0], h1[1], h1[2], h1[3]}, o[d0], 0, 0, 0); \
        o[d0] = __builtin_amdgcn_mfma_f32_32x32x16_bf16(pa2, (bf16x8){l2[0], l2[1], l2[2], l2[3], h2[0], h2[1], h2[2], h2[3]}, o[d0], 0, 0, 0); \
        o[d0] = __builtin_amdgcn_mfma_f32_32x32x16_bf16(pa3, (bf16x8){l3[0], l3[1], l3[2], l3[3], h3[0], h3[1], h3[2], h3[3]}, o[d0], 0, 0, 0); } while (0)
    A2_PV_D0(0); A2_PV_D0(1); A2_PV_D0(2); A2_PV_D0(3);
#undef A2_PV_D0
#undef A2_TRRD
}
struct BlockRef { const bf16* Q; const bf16* K; const bf16* V; const bf16* G; bf16* Mx; int P0; int mapc; };
#define A2_VMW() asm volatile("s_waitcnt vmcnt(0)" ::: "memory")
__device__ __forceinline__ void unit_block(const BlockRef& cur, char* lds, float lam, const float* sw, float osc) {
    int tid_ = threadIdx.x; asm volatile("" : "+v"(tid_)); const int tid = tid_, wid = __builtin_amdgcn_readfirstlane(tid >> 6), lane = tid & 63, r32 = lane & 31, hi = lane >> 5;
    const bool grpB = wid >= 4;
    const int NT = (cur.P0 + QB - 1) / KVBLK + 1;
    const int qlo = cur.P0 + wid * QBLK, qm = qlo + r32 - 4 * hi;
    char* V_lds = lds; char* K_lds = lds + 2 * SHM_V;
    float* ws = (float*)(lds + LDS_WS) + wid * 64; float* li_l = ws, * al_l = ws + 32;
    float m_reg = 0.f, l_reg = 0; f32x16 o[4] = {}; f32x16 negm = {};
    const int sr = tid >> 4, sc = (tid & 15) * 8, vst0 = v_st(sr, sc), vst1 = v_st(32 + sr, sc), kr = tid >> 3, kc = (tid & 7) * 8, kws = A2_KSWZ(kr, kc * 2);
    const int vb0 = (int)(uintptr_t)V_lds + v_rd_base(lane);
    const bf16* Kh = cur.K + (size_t)kr * PQ + kc; const bf16* Vh = cur.V + (size_t)sr * PQ + sc;
    bf16x8 qr[4], st_k, st_v0, st_v1;
#define A3_LDK(t) (st_k = load8(Kh + (size_t)(t) * KVBLK * PQ))
#define A3_LDV(t) do { st_v0 = load8(Vh + (size_t)(t) * KVBLK * PQ); st_v1 = load8(Vh + (size_t)((t) * KVBLK + 32) * PQ); } while (0)
#define A3_WRK(bf) (*(bf16x8*)(K_lds + (bf) * SHM_K + kws) = st_k)
#define A3_WRV(bf) do { *(bf16x8*)(V_lds + (bf) * SHM_V + vst0) = st_v0; *(bf16x8*)(V_lds + (bf) * SHM_V + vst1) = st_v1; } while (0)
#pragma unroll
    for (int d0 = 0; d0 < 4; ++d0) qr[d0] = load8(cur.Q + (size_t)(wid * QBLK + r32) * PQ + d0 * 16 + hi * 8);
    { A3_LDK(0); A3_LDV(0); const bf16x8 k1 = load8(Kh + (size_t)KVBLK * PQ); A2_VMW(); A3_WRK(0); A3_WRV(0); *(bf16x8*)(K_lds + SHM_K + kws) = k1; }
    A3_LDK(2); A3_LDV(1);
    __syncthreads();
    f32x16 p0, p1; float alpha; bf16x8 pa0, pa1, pa2, pa3;
#define A3_RESC(a) do { if (__any((a) < 1.f)) { if (hi == 0) al_l[r32] = (a); asm volatile("s_waitcnt lgkmcnt(0)" ::: "memory"); \
        _Pragma("unroll") for (int d_ = 0; d_ < 4; ++d_) _Pragma("unroll") for (int r = 0; r < 16; ++r) o[d_][r] *= al_l[crow(r, hi)]; } } while (0)
#define A3_SOFTMAX(t) do { const int kb_ = (t) * KVBLK; if (kb_ + KVBLK - 1 > qlo) mask_tile(p0, p1, qm - kb_); \
        softmax_tile(p0, p1, m_reg, negm, alpha, l_reg, (t) == 0, pa0, pa1, pa2, pa3); A3_RESC(alpha); } while (0)
#define A3_MFMA(t, KBN, VB) do { } while (0)
#define A3_STAGE(t, KBN, VB) do { A2_VMW(); A3_WRK(VB); A3_WRV(KBN); A2_SBAR(); { const int tk_ = (t) + 3 < NT ? (t) + 3 : NT - 1, tv_ = (t) + 2 < NT ? (t) + 2 : NT - 1; A3_LDK(tk_); A3_LDV(tv_); } A2_SBAR(); } while (0)
#undef A3_MFMA
#define A3_MFMA(t, KBN, VB) do { bf16x8 kf[8]; kload<KBN>(kf, K_lds, r32, hi); qkt(p0, p1, kf, qr, negm); A2_SBAR(); pv_tile<VB>(o, vb0, pa0, pa1, pa2, pa3); } while (0)
#define A3_KL(KB) do { A2_SBAR(); kload<KB>(kf, K_lds, r32, hi); } while (0)
    if (!grpB) {
        { bf16x8 kf[8]; kload<0>(kf, K_lds, r32, hi); qkt(p0, p1, kf, qr, negm); } __syncthreads();
        A3_SOFTMAX(0); __syncthreads();
        for (int t = 0; t < NT; t += 2) {
            A3_STAGE(t, 1, 0); A3_MFMA(t, 1, 0); __syncthreads(); A3_SOFTMAX(t + 1); __syncthreads();
            A3_STAGE(t + 1, 0, 1); A3_MFMA(t + 1, 0, 1); __syncthreads(); if (t + 2 < NT) { A3_SOFTMAX(t + 2); } __syncthreads();
        }
    } else {
        __syncthreads();
        { bf16x8 kf[8]; kload<0>(kf, K_lds, r32, hi); qkt(p0, p1, kf, qr, negm); } __syncthreads();
        for (int t = 0; t < NT; t += 2) {
            A3_STAGE(t, 1, 0); A3_SOFTMAX(t); __syncthreads(); A3_MFMA(t, 1, 0); __syncthreads();
            A3_STAGE(t + 1, 0, 1); A3_SOFTMAX(t + 1); __syncthreads(); A3_MFMA(t + 1, 0, 1); __syncthreads();
        }
    }
    if (hi == 0) li_l[r32] = l_reg; asm volatile("s_waitcnt lgkmcnt(0)" ::: "memory");
    float rli[16];
#pragma unroll
    for (int r = 0; r < 16; ++r) rli[r] = __builtin_amdgcn_rcpf(li_l[crow(r, hi)]);
    { bf16* stg = (bf16*)(lds + LDS_OST) + wid * (QBLK * DV);
      if (cur.mapc == 0) {
#pragma unroll
        for (int r = 0; r < 16; ++r) { const int orow = crow(r, hi);
#pragma unroll
          for (int d0 = 0; d0 < 4; ++d0) { const float v = o[d0][r] * rli[r]; const unsigned u = __builtin_bit_cast(unsigned, v); stg[orow * DV + d0 * 32 + r32] = (bf16)((u + 0x7fffu + ((u >> 16) & 1u)) >> 16); } }
      } else {
        u32x4 gv[8]; const bf16* Gw = cur.G + (size_t)(wid * QBLK) * PQ;
#pragma unroll
        for (int i = 0; i < 8; ++i) gv[i] = *(const u32x4*)(Gw + (size_t)(i * 4 + (lane >> 4)) * PQ + (lane & 15) * 8);
        float swv[8];
#pragma unroll
        for (int j = 0; j < 8; ++j) swv[j] = sw[(lane & 15) * 8 + j] * osc;
#pragma unroll
        for (int r = 0; r < 16; ++r) { const int orow = crow(r, hi);
#pragma unroll
          for (int d0 = 0; d0 < 4; ++d0) { const int idx = orow * DV + d0 * 32 + r32; const float v = __uint_as_float((unsigned)stg[idx] << 16) - lam * (o[d0][r] * rli[r]);
            const unsigned u = __builtin_bit_cast(unsigned, v); stg[idx] = (bf16)((u + 0x7fffu + ((u >> 16) & 1u)) >> 16); } }
        asm volatile("s_waitcnt lgkmcnt(0)" ::: "memory");
        bf16* Mw = cur.Mx + (size_t)(wid * QBLK) * PO;
#pragma unroll
        for (int i = 0; i < 8; ++i) { const int row = i * 4 + (lane >> 4), ch = lane & 15; const u32x4 v = *(const u32x4*)(stg + row * DV + ch * 8);
          float d[8] = {__uint_as_float(v.x << 16), __uint_as_float(v.x & 0xffff0000u), __uint_as_float(v.y << 16), __uint_as_float(v.y & 0xffff0000u), __uint_as_float(v.z << 16), __uint_as_float(v.z & 0xffff0000u), __uint_as_float(v.w << 16), __uint_as_float(v.w & 0xffff0000u)};
          const u32x4 g = gv[i];
          const float gg[8] = {__uint_as_float(g.x << 16), __uint_as_float(g.x & 0xffff0000u), __uint_as_float(g.y << 16), __uint_as_float(g.y & 0xffff0000u), __uint_as_float(g.z << 16), __uint_as_float(g.z & 0xffff0000u), __uint_as_float(g.w << 16), __uint_as_float(g.w & 0xffff0000u)};
          float ss = 0.f;
#pragma unroll
          for (int j = 0; j < 8; ++j) ss += d[j] * d[j];
          ss += __int_as_float(__builtin_amdgcn_update_dpp(0, __float_as_int(ss), 0x128, 0xf, 0xf, false)); ss += __int_as_float(__builtin_amdgcn_update_dpp(0, __float_as_int(ss), 0x124, 0xf, 0xf, false));
          ss += __int_as_float(__builtin_amdgcn_update_dpp(0, __float_as_int(ss), 0x122, 0xf, 0xf, false)); ss += __int_as_float(__builtin_amdgcn_update_dpp(0, __float_as_int(ss), 0x121, 0xf, 0xf, false));
          const float rs = __builtin_amdgcn_rsqf(ss * (1.0f / 128.0f) + 1e-5f);
#pragma unroll
          for (int j = 0; j < 8; ++j) d[j] = d[j] * rs * swv[j] * gg[j];
          u32x4 w; w.x = cvtpk(d[0], d[1]); w.y = cvtpk(d[2], d[3]); w.z = cvtpk(d[4], d[5]); w.w = cvtpk(d[6], d[7]);
          *(u32x4*)(Mw + (size_t)row * PO + ch * 8) = w; }
      } }
    __syncthreads();
#undef A3_LDK
#undef A3_LDV
#undef A3_WRK
#undef A3_WRV
#undef A3_RESC
#undef A3_SOFTMAX
#undef A3_MFMA
#undef A3_STAGE
#undef A3_KL
}
#undef A2_VMW
struct AttnTensors { const bf16* P; bf16* Mx; };
__device__ __forceinline__ BlockRef unit_ref(const AttnTensors& T, int vcu, int i) {
    const int s = vcu & 7, bh = vcu >> 3, b = bh >> 3, h = bh & 7, c = i & 1, qb = (i & 2) ? s : (NQB - 1 - s);
    BlockRef r; const size_t row0 = (size_t)b * SEQ, rowq = row0 + (size_t)qb * QB;
    r.Q = T.P + rowq * PQ + h * 128 + c * 64; r.K = T.P + row0 * PQ + 1024 + h * 128 + c * 64; r.V = T.P + row0 * PQ + 2048 + h * 128;
    r.G = T.P + rowq * PQ + 3072 + h * 128; r.Mx = T.Mx + rowq * PO + h * 128; r.P0 = qb * QB; r.mapc = c; return r;
}
__device__ __forceinline__ void attn_phase(char* lds, const AttnTensors& T, int vcu, float lam, const float* sw, float osc) {
    if (vcu >= 256) return;
    for (int i = 0; i < 4; ++i) { const BlockRef cur = unit_ref(T, vcu, i); unit_block(cur, lds, lam, sw, osc); }
}
#undef A2_SBAR
#undef A2_KSWZ
}

constexpr int NWAVES = 8;
#ifndef ATTN_V2
#define ATTN_V2 1
#endif
#ifndef TAIL_COPIES
#define TAIL_COPIES 1
#endif
#ifndef MK_PER_PHASE
#define MK_PER_PHASE 0
#endif
constexpr int NPHASE = 8;

constexpr int BATCH = 4, SEQ = 4096, D = 2048, DEPTH = 2, NPROJ = 7680, NHEAD = 8;
constexpr int M = BATCH * SEQ;
constexpr float NORM_EPS = 1e-5f, LN_EPS = 1e-5f;
constexpr int PC_Q = 0, PC_K = 1024, PC_V = 2048, PC_GA = 3072, PC_U = 4096, PC_VS = 4608, PC_GB = 5120, PC_XC = 5632, PC_BG = 6144, PC_CG = 6656, PC_GC = 7168;

constexpr size_t MiB = 1u << 20;
constexpr size_t WS_CTL = 0, CTL_ZERO_BYTES = 1 * MiB;
constexpr size_t WS_SSQ1 = 256 * 1024;
constexpr size_t WS_SSQ0 = 1 * MiB;
constexpr size_t WS_ROPE = 2 * MiB;
constexpr size_t WS_TRIL = 3 * MiB;
constexpr size_t WS_WIN = 4 * MiB;
constexpr size_t WS_WOUT = 64 * MiB;
constexpr size_t WS_XB = 80 * MiB;
constexpr size_t WS_MIX = 144 * MiB;
constexpr size_t WS_PROJ = 208 * MiB;
constexpr size_t WS_END = 448 * MiB;
static_assert(WS_WIN + (size_t)DEPTH * NPROJ * D * 2 <= WS_WOUT && WS_WOUT + (size_t)DEPTH * D * D * 2 <= WS_XB && WS_XB + (size_t)M * D * 2 <= WS_MIX && WS_MIX + (size_t)M * D * 2 <= WS_PROJ && WS_PROJ + (size_t)M * NPROJ * 2 <= WS_END, "d_ws map");
constexpr int CW_BAR = 4096;

constexpr int RING_OFF = 0, RING_BYTES = 131072;
constexpr int LDSCTL_OFF = RING_BYTES, MISC_OFF = LDSCTL_OFF + 320;
constexpr int LDS_BYTES = 147456;
static_assert(MISC_OFF + 128 <= LDS_BYTES, "LDS map");

#define GAS __attribute__((address_space(1)))
#define LAS __attribute__((address_space(3)))
typedef unsigned short bf16;
typedef unsigned v4u __attribute__((ext_vector_type(4)));
typedef unsigned v2u __attribute__((ext_vector_type(2)));
typedef float f32x4 __attribute__((ext_vector_type(4)));
typedef short bf16x8 __attribute__((ext_vector_type(8)));
typedef GAS unsigned gu32;
#define RLX_AGENT __ATOMIC_RELAXED, __HIP_MEMORY_SCOPE_AGENT
#define LDS_WAIT() asm volatile("s_waitcnt lgkmcnt(0)" ::: "memory")
#define VM_WAIT() asm volatile("s_waitcnt vmcnt(0)" ::: "memory")
__device__ __forceinline__ unsigned f2bf(float f) { unsigned u = __builtin_bit_cast(unsigned, f); return (u + 0x7fffu + ((u >> 16) & 1u)) >> 16; }
__device__ __forceinline__ unsigned pk2(float lo, float hi) { return f2bf(lo) | (f2bf(hi) << 16); }
__device__ __forceinline__ float bflo(unsigned w) { return __uint_as_float(w << 16); }
__device__ __forceinline__ float bfhi(unsigned w) { return __uint_as_float(w & 0xffff0000u); }
__device__ __forceinline__ float bf1(bf16 b) { return __uint_as_float((unsigned)b << 16); }

#define XB_TMO      128
#define XB_XCNT(j)  (256  + 64 * (j))
#define XB_XSUB(j)  (1280 + 64 * (j))
#define XB_XGEN(j)  (2304 + 64 * (j))
#define XB_TOP      3328
#define XB_TOPGEN   3392
#define XCD_BAR_WORDS 3456
#define XB_SPIN_CAP (1u << 18)

__device__ __forceinline__ unsigned xb_ld(unsigned* p)              { return __hip_atomic_load(p, __ATOMIC_RELAXED, __HIP_MEMORY_SCOPE_AGENT); }
__device__ __forceinline__ unsigned xb_add(unsigned* p, unsigned v) { return __hip_atomic_fetch_add(p, v, __ATOMIC_RELAXED, __HIP_MEMORY_SCOPE_AGENT); }
__device__ __forceinline__ unsigned xb_xcc_id() { return (unsigned)__builtin_amdgcn_s_getreg((3 << 11) | 20) & 0xFu; }
#define XB_SPIN(cond, bar) do { unsigned _sp = 0; while (cond) { __builtin_amdgcn_s_sleep(1); \
    if ((++_sp & 255u) == 0u) { if (xb_ld(&(bar)[XB_TMO])) break; if (_sp > XB_SPIN_CAP) { atomicAdd(&(bar)[XB_TMO], 1u); break; } } } } while (0)

struct XcdBarrier {
    unsigned* bar; unsigned x;
    volatile LAS unsigned* st;
};

__device__ __forceinline__ XcdBarrier xcd_barrier_post(unsigned* bar, volatile LAS unsigned* st) {
    XcdBarrier b; b.bar = bar; b.x = xb_xcc_id(); b.st = st;
    if (threadIdx.x == 0) (void)xb_add(&bar[XB_XCNT(b.x)], 1u);
    return b;
}
__device__ __forceinline__ void xcd_barrier_complete(unsigned* bar, unsigned x, unsigned& nloc, unsigned& nx) {
    const unsigned G = gridDim.x * gridDim.y * gridDim.z;
    unsigned sum, cnt, mine, sp = 0u;
    for (;;) {
        sum = 0u; cnt = 0u; mine = 0u;
#pragma unroll
        for (unsigned j = 0; j < 16; ++j) { const unsigned c = xb_ld(&bar[XB_XCNT(j)]); sum += c; cnt += (c > 0u) ? 1u : 0u; mine = (j == x) ? c : mine; }
        if (sum == G) break;
        __builtin_amdgcn_s_sleep(1);
        if ((++sp & 255u) == 0u) { if (xb_ld(&bar[XB_TMO])) break; if (sp > XB_SPIN_CAP) { atomicAdd(&bar[XB_TMO], 1u); break; } }
    }
    nloc = mine > 0u ? mine : 1u; nx = cnt > 0u ? cnt : 1u;
}

__device__ __forceinline__ void xcd_barrier(const XcdBarrier& b) {
    asm volatile("s_waitcnt vmcnt(0)" ::: "memory");
    __syncthreads();
    if (threadIdx.x == 0) {
        unsigned* bar = b.bar;
        __builtin_amdgcn_s_waitcnt(0);
        unsigned nloc = b.st[0], nx = b.st[1];
        if (nloc == 0u) { xcd_barrier_complete(bar, b.x, nloc, nx); b.st[0] = nloc; b.st[1] = nx; }
        const unsigned old = xb_add(&bar[XB_XSUB(b.x)], 1u);
        const unsigned gen = old / nloc;
        if (old + 1u == (gen + 1u) * nloc) {
            __builtin_amdgcn_fence(__ATOMIC_RELEASE, "agent");
            asm volatile("s_waitcnt vmcnt(0)" ::: "memory");
            const unsigned og = xb_add(&bar[XB_TOP], 1u);
            const unsigned tg = og / nx;
            if (og + 1u == (tg + 1u) * nx) xb_add(&bar[XB_TOPGEN], 1u);
            else XB_SPIN(xb_ld(&bar[XB_TOPGEN]) == tg, bar);
            __builtin_amdgcn_fence(__ATOMIC_ACQUIRE, "agent");
            xb_add(&bar[XB_XGEN(b.x)], 1u);
            asm volatile("s_waitcnt vmcnt(0)" ::: "memory");
        } else {
            XB_SPIN(xb_ld(&bar[XB_XGEN(b.x)]) == gen, bar);
            __builtin_amdgcn_fence(__ATOMIC_ACQUIRE, "agent");
            asm volatile("s_waitcnt vmcnt(0)" ::: "memory");
        }
    }
    __syncthreads();
}

struct Frame {
    LAS unsigned char* lds;
    int tid, lane, wave;
    int vcu, G;
};
__device__ __forceinline__ void frame_ids(Frame& F) {
    int t = threadIdx.x; asm volatile("" : "+v"(t));
    F.tid = t; F.lane = t & 63; F.wave = __builtin_amdgcn_readfirstlane(t >> 6);
    int bx = blockIdx.x; asm volatile("" : "+s"(bx));
    F.G = gridDim.x; F.vcu = (F.G % 8 == 0) ? (bx % 8) * (F.G / 8) + bx / 8 : bx;
}

template <int CTRL> __device__ __forceinline__ float dpp_f(float v) { return __int_as_float(__builtin_amdgcn_update_dpp(0, __float_as_int(v), CTRL, 0xf, 0xf, false)); }
__device__ __forceinline__ float row16_sum(float v) { v += dpp_f<0x128>(v); v += dpp_f<0x124>(v); v += dpp_f<0x122>(v); v += dpp_f<0x121>(v); return v; }
__device__ __forceinline__ float wave_sum(float v) {
    v = row16_sum(v);
    const int vi = __float_as_int(v);
    const float a = __int_as_float(__builtin_amdgcn_readlane(vi, 0)), b = __int_as_float(__builtin_amdgcn_readlane(vi, 16)), c = __int_as_float(__builtin_amdgcn_readlane(vi, 32)), d = __int_as_float(__builtin_amdgcn_readlane(vi, 48));
    return (a + b) + (c + d);
}
__device__ __forceinline__ int qk_dest_row(int n) { if (n >= 2048) return n; const int v = n >> 6, d = n & 63; const int j = (d < 32) ? ((d >> 2) * 8 + (d & 3)) : (((d - 32) >> 2) * 8 + 4 + (d & 3)); return (v << 6) + j; }
__device__ __forceinline__ void p0_transpose_item(const float* W, int K, int N, bf16* WT, const float* kscale, bool perm, int item, int lane) {
    const int nblk = N / 64, kb = item / nblk, nb = item % nblk, k0 = 64 * kb, n = 64 * nb + lane;
    const GAS float* src = (const GAS float*)W + (size_t)k0 * N + n;
    float v[64];
#pragma unroll
    for (int i = 0; i < 64; ++i) v[i] = src[(size_t)i * N];
    if (kscale) {
#pragma unroll
        for (int i = 0; i < 64; ++i) v[i] *= kscale[k0 + i];
    }
    const int nd = perm ? qk_dest_row(n) : n;
    GAS v4u* dst = (GAS v4u*)(WT + (size_t)nd * K + k0);
#pragma unroll
    for (int j = 0; j < 8; ++j) { v4u o; o.x = pk2(v[8 * j], v[8 * j + 1]); o.y = pk2(v[8 * j + 2], v[8 * j + 3]); o.z = pk2(v[8 * j + 4], v[8 * j + 5]); o.w = pk2(v[8 * j + 6], v[8 * j + 7]); dst[j] = o; }
}
struct Args { const float* in[15]; float* out; unsigned char* ws; int ph_lo, ph_hi; };
typedef const __attribute__((address_space(4))) Args* KArgs;
__device__ __forceinline__ KArgs kargs() { KArgs p = (KArgs)__builtin_amdgcn_kernarg_segment_ptr(); asm volatile("" : "+s"(p)); return p; }
enum { I_X = 0, I_NORMW, I_WIN, I_LQ1, I_LK1, I_LQ2, I_LK2, I_SUBLN, I_LNG, I_LNB, I_WS, I_BS, I_CONVW, I_WOUT, I_FINALW };
constexpr int I_IN = (D / 64) * (NPROJ / 64), I_OUT = (D / 64) * (D / 64), I_LAYER = I_IN + I_OUT;
__device__ __forceinline__ void weight_items(Frame& F, int lo, int hi, int w, int nw) {
    KArgs ka = kargs(); unsigned char* const ws = ka->ws;
    bf16* win = (bf16*)(ws + WS_WIN); bf16* wout = (bf16*)(ws + WS_WOUT);
    const float* w_in = ka->in[I_WIN]; const float* w_out = ka->in[I_WOUT]; const float* norm_w = ka->in[I_NORMW];
    for (int it = lo + w; it < hi; it += nw) {
        int r = it; const int l = r / I_LAYER; r -= l * I_LAYER;
        if (r < I_IN) p0_transpose_item(w_in + (size_t)l * D * NPROJ, D, NPROJ, win + (size_t)l * NPROJ * D, norm_w + l * D, true, r, F.lane);
        else p0_transpose_item(w_out + (size_t)l * D * D, D, D, wout + (size_t)l * D * D, nullptr, false, r - I_IN, F.lane);
    }
}
__device__ __forceinline__ void p0_prologue(Frame& F) {
    KArgs ka = kargs(); unsigned char* const ws = ka->ws;
    const int gw = F.vcu * NWAVES + F.wave, NGW = F.G * NWAVES;
    weight_items(F, 0, TAIL_COPIES ? I_IN : DEPTH * I_LAYER, gw, NGW);
    bf16* xb = (bf16*)(ws + WS_XB); float* ssq0 = (float*)(ws + WS_SSQ0); const float* x = ka->in[I_X];
    for (int m0 = gw * 2; m0 < M; m0 += NGW * 2) {
        f32x4 v[2][8];
#pragma unroll
        for (int i = 0; i < 2; ++i)
#pragma unroll
            for (int j = 0; j < 8; ++j) v[i][j] = ((const GAS f32x4*)(x + (size_t)(m0 + i) * D))[64 * j + F.lane];
#pragma unroll
        for (int i = 0; i < 2; ++i) { float s = 0.f;
            GAS unsigned long long* o8 = (GAS unsigned long long*)(xb + (size_t)(m0 + i) * D) + F.lane;
#pragma unroll
            for (int j = 0; j < 8; ++j) { s += (v[i][j].x * v[i][j].x + v[i][j].y * v[i][j].y) + (v[i][j].z * v[i][j].z + v[i][j].w * v[i][j].w);
                o8[64 * j] = (unsigned long long)pk2(v[i][j].x, v[i][j].y) | ((unsigned long long)pk2(v[i][j].z, v[i][j].w) << 32); }
            s = wave_sum(s);
            if (F.lane == 0) ssq0[m0 + i] = s; }
    }
    const int gt = F.vcu * (NWAVES * 64) + F.tid, NGT = F.G * NWAVES * 64;
    float* rope = (float*)(ws + WS_ROPE);
    for (int e = gt; e < SEQ * 32; e += NGT) {
        const int pos = e >> 5, i = e & 31;
        double f = 1.0; for (int k = 0; k < i; ++k) f *= 0.74989420933245582730;
        const double rev = (double)pos * f * 0.15915494309189533577; const double fr = rev - __builtin_floor(rev);
        rope[pos * 64 + i] = __builtin_amdgcn_cosf((float)fr); rope[pos * 64 + 32 + i] = __builtin_amdgcn_sinf((float)fr);
    }
    bf16* tril = (bf16*)(ws + WS_TRIL); const float* w_s = ka->in[I_WS];
    for (int e = gt; e < DEPTH * 4 * 128 * 128; e += NGT) { const int s = e & 127, t = (e >> 7) & 127; tril[e] = (s <= t) ? (bf16)f2bf(w_s[e]) : (bf16)0; }
}

__device__ __forceinline__ void unpack8(const v4u w, float (&f)[8]) { f[0] = bflo(w.x); f[1] = bfhi(w.x); f[2] = bflo(w.y); f[3] = bfhi(w.y); f[4] = bflo(w.z); f[5] = bfhi(w.z); f[6] = bflo(w.w); f[7] = bfhi(w.w); }
__device__ __forceinline__ v4u pack8(const float (&f)[8]) { v4u w; w.x = pk2(f[0], f[1]); w.y = pk2(f[2], f[3]); w.z = pk2(f[4], f[5]); w.w = pk2(f[6], f[7]); return w; }
__device__ __forceinline__ void sgu_item(Frame& F, unsigned char* ws, const float* ln_g, const float* ln_b, const float* b_s, int layer, int item) {
    const int chunk = item >> 2, g = item & 3, row0 = chunk * 128, lane = F.lane, wave = F.wave;
    const bf16* proj = (const bf16*)(ws + WS_PROJ); bf16* mix = (bf16*)(ws + WS_MIX);
    LAS bf16* vnT = (LAS bf16*)(F.lds + RING_OFF);
    const float g0 = ln_g[layer * 512 + g * 128 + lane], g1 = ln_g[layer * 512 + g * 128 + 64 + lane], b0 = ln_b[layer * 512 + g * 128 + lane], b1 = ln_b[layer * 512 + g * 128 + 64 + lane];
#pragma unroll
    for (int hb = 0; hb < 2; ++hb) {
        v4u raw[8]; bf16 e0[8], e1[8];
#pragma unroll
        for (int tt = 0; tt < 8; ++tt) { const bf16* rp = proj + (size_t)(row0 + 16 * wave + 8 * hb + tt) * NPROJ + PC_VS;
            raw[tt] = *(const GAS v4u*)(rp + 8 * lane); e0[tt] = rp[g * 128 + lane]; e1[tt] = rp[g * 128 + 64 + lane]; }
#pragma unroll
        for (int tt = 0; tt < 8; ++tt) { const int tl = 16 * wave + 8 * hb + tt;
            float f[8]; unpack8(raw[tt], f);
            float s1 = ((f[0] + f[1]) + (f[2] + f[3])) + ((f[4] + f[5]) + (f[6] + f[7]));
            const float mean = wave_sum(s1) * (1.0f / 512.0f); float s2 = 0.f;
#pragma unroll
            for (int j = 0; j < 8; ++j) { const float d = f[j] - mean; s2 += d * d; }
            const float rstd = __builtin_amdgcn_rsqf(wave_sum(s2) * (1.0f / 512.0f) + LN_EPS);
            vnT[lane * 136 + tl] = (bf16)f2bf((bf1(e0[tt]) - mean) * rstd * g0 + b0);
            vnT[(64 + lane) * 136 + tl] = (bf16)f2bf((bf1(e1[tt]) - mean) * rstd * g1 + b1); }
    }
    LDS_WAIT(); __syncthreads();
    bf16x8 a[4];
#pragma unroll
    for (int ks = 0; ks < 4; ++ks) a[ks] = *(const LAS bf16x8*)(vnT + (16 * wave + (lane & 15)) * 136 + 32 * ks + 8 * (lane >> 4));
    const bf16* tril = (const bf16*)(ws + WS_TRIL) + (size_t)(layer * 4 + g) * 128 * 128;
#pragma unroll
    for (int th = 0; th < 2; ++th) {
        bf16x8 b[4][4]; v2u u2[4], s2[4]; float bs[4];
#pragma unroll
        for (int q = 0; q < 4; ++q) { const int t = 16 * (4 * th + q) + (lane & 15), row = row0 + t, ch4 = g * 128 + 16 * wave + 4 * (lane >> 4);
#pragma unroll
            for (int ks = 0; ks < 4; ++ks) b[q][ks] = *(const GAS bf16x8*)(tril + t * 128 + 32 * ks + 8 * (lane >> 4));
            u2[q] = *(const GAS v2u*)(proj + (size_t)row * NPROJ + PC_U + ch4); s2[q] = *(const GAS v2u*)(proj + (size_t)row * NPROJ + PC_GB + ch4); bs[q] = b_s[(layer * 4 + g) * 128 + t]; }
#pragma unroll
        for (int q = 0; q < 4; ++q) { const int t = 16 * (4 * th + q) + (lane & 15), row = row0 + t, ch4 = g * 128 + 16 * wave + 4 * (lane >> 4);
            f32x4 acc = (f32x4){0.f, 0.f, 0.f, 0.f};
#pragma unroll
            for (int ks = 0; ks < 4; ++ks) acc = __builtin_amdgcn_mfma_f32_16x16x32_bf16(a[ks], b[q][ks], acc, 0, 0, 0);
            v2u o; o.x = pk2(bflo(u2[q].x) * (acc[0] + bs[q]) * bflo(s2[q].x), bfhi(u2[q].x) * (acc[1] + bs[q]) * bfhi(s2[q].x)); o.y = pk2(bflo(u2[q].y) * (acc[2] + bs[q]) * bflo(s2[q].y), bfhi(u2[q].y) * (acc[3] + bs[q]) * bfhi(s2[q].y));
            *(GAS v2u*)(mix + (size_t)row * D + 1024 + ch4) = o; }
    }
    LDS_WAIT(); __syncthreads();
}
__device__ __forceinline__ float lam_of(KArgs ka, int layer, int lane) {
    const float a = wave_sum(ka->in[I_LQ1][layer * 64 + lane] * ka->in[I_LK1][layer * 64 + lane]), b = wave_sum(ka->in[I_LQ2][layer * 64 + lane] * ka->in[I_LK2][layer * 64 + lane]);
    const float lam_init = 0.8f - 0.6f * __expf(-0.3f * (float)layer);
    return __expf(a) - __expf(b) + lam_init;
}
__device__ __forceinline__ void mix_phase(Frame& F, int layer) {
    KArgs ka = kargs(); unsigned char* const ws = ka->ws;
    { const float* ln_g = ka->in[I_LNG]; const float* ln_b = ka->in[I_LNB]; const float* b_s = ka->in[I_BS];
      for (int it = F.vcu; it < 512; it += F.G) sgu_item(F, ws, ln_g, ln_b, b_s, layer, it); }
    const bf16* proj = (const bf16*)(ws + WS_PROJ); bf16* mix = (bf16*)(ws + WS_MIX); const bf16* atto = (const bf16*)ka->out;
    const float* subln_w = ka->in[I_SUBLN]; const float* conv_w = ka->in[I_CONVW];
    const int lane = F.lane, gw = F.vcu * NWAVES + F.wave, NGW = F.G * NWAVES;
    const float lam_init = 0.8f - 0.6f * __expf(-0.3f * (float)layer), lam = lam_of(ka, layer, lane);
    for (int blk = gw; blk < M / 8; blk += NGW) {
        const int r0 = blk * 8;
#if !ATTN_V2
        { float sw[8];
#pragma unroll
          for (int j = 0; j < 8; ++j) sw[j] = subln_w[layer * 128 + 8 * (lane & 15) + j] * (1.0f - lam_init);
#pragma unroll
          for (int hb = 0; hb < 2; ++hb) {
            v4u r1[4][2], r2[4][2], rg[4][2];
#pragma unroll
            for (int i = 0; i < 4; ++i)
#pragma unroll
                for (int hf = 0; hf < 2; ++hf) { const int row = r0 + 4 * hb + i, col = hf * 512 + 8 * lane;
                    r1[i][hf] = *(const GAS v4u*)(atto + (size_t)row * D + col); r2[i][hf] = *(const GAS v4u*)(atto + (size_t)row * D + 1024 + col); rg[i][hf] = *(const GAS v4u*)(proj + (size_t)row * NPROJ + PC_GA + col); }
#pragma unroll
            for (int i = 0; i < 4; ++i)
#pragma unroll
                for (int hf = 0; hf < 2; ++hf) { const int row = r0 + 4 * hb + i, col = hf * 512 + 8 * lane;
                    float o1[8], o2[8], sg[8], y[8]; unpack8(r1[i][hf], o1); unpack8(r2[i][hf], o2); unpack8(rg[i][hf], sg);
                    float ss = 0.f;
#pragma unroll
                    for (int j = 0; j < 8; ++j) { o1[j] -= lam * o2[j]; ss += o1[j] * o1[j]; }
                    const float rs = __builtin_amdgcn_rsqf(row16_sum(ss) * (1.0f / 128.0f) + NORM_EPS);
#pragma unroll
                    for (int j = 0; j < 8; ++j) y[j] = o1[j] * rs * sw[j] * sg[j];
                    *(GAS v4u*)(mix + (size_t)row * D + col) = pack8(y); }
          } }
#endif
        { float cw0[8], cw1[8], cw2[8];
#pragma unroll
          for (int j = 0; j < 8; ++j) { cw0[j] = conv_w[(layer * 3 + 0) * 512 + 8 * lane + j]; cw1[j] = conv_w[(layer * 3 + 1) * 512 + 8 * lane + j]; cw2[j] = conv_w[(layer * 3 + 2) * 512 + 8 * lane + j]; }
#pragma unroll
          for (int hb = 0; hb < 2; ++hb) { const int rb = r0 + 4 * hb; const bool halo = (rb & (SEQ - 1)) != 0;
            v4u rx[6], rc[6], rbg[4], rgc[4];
#pragma unroll
            for (int i = 0; i < 6; ++i) { const int row = (halo || i >= 2) ? rb - 2 + i : rb; const bf16* rp = proj + (size_t)row * NPROJ + 8 * lane; rx[i] = *(const GAS v4u*)(rp + PC_XC); rc[i] = *(const GAS v4u*)(rp + PC_CG); }
#pragma unroll
            for (int i = 0; i < 4; ++i) { const bf16* rp = proj + (size_t)(rb + i) * NPROJ + 8 * lane; rbg[i] = *(const GAS v4u*)(rp + PC_BG); rgc[i] = *(const GAS v4u*)(rp + PC_GC); }
            float z[6][8];
#pragma unroll
            for (int i = 0; i < 6; ++i) { float a[8], b[8]; unpack8(rx[i], a); unpack8(rc[i], b);
#pragma unroll
                for (int j = 0; j < 8; ++j) z[i][j] = (halo || i >= 2) ? a[j] * b[j] : 0.f; }
#pragma unroll
            for (int i = 0; i < 4; ++i) { float bg[8], gc[8], y[8]; unpack8(rbg[i], bg); unpack8(rgc[i], gc);
#pragma unroll
                for (int j = 0; j < 8; ++j) y[j] = bg[j] * (cw0[j] * z[i][j] + cw1[j] * z[i + 1][j] + cw2[j] * z[i + 2][j]) * gc[j];
                *(GAS v4u*)(mix + (size_t)(rb + i) * D + 1536 + 8 * lane) = pack8(y); }
          } }
    }
}
__device__ __forceinline__ void final_norm(Frame& F) {
    KArgs ka = kargs(); float* const out = ka->out; const float* final_w = ka->in[I_FINALW]; const bf16* xb = (const bf16*)(ka->ws + WS_XB);
    const int gw = F.vcu * NWAVES + F.wave, NGW = F.G * NWAVES;
    for (int m0 = gw * 4; m0 < M; m0 += NGW * 4) {
        v4u raw[4][4];
#pragma unroll
        for (int i = 0; i < 4; ++i)
#pragma unroll
            for (int j = 0; j < 4; ++j) raw[i][j] = ((const GAS v4u*)(xb + (size_t)(m0 + i) * D))[64 * j + F.lane];
#pragma unroll
        for (int i = 0; i < 4; ++i) { float v[4][8]; float s = 0.f;
#pragma unroll
            for (int j = 0; j < 4; ++j) { unpack8(raw[i][j], v[j]);
#pragma unroll
                for (int e = 0; e < 8; ++e) s += v[j][e] * v[j][e]; }
            const float rs = __builtin_amdgcn_rsqf(wave_sum(s) * (1.0f / 2048.0f) + NORM_EPS);
            GAS f32x4* orow = (GAS f32x4*)(out + (size_t)(m0 + i) * D);
#pragma unroll
            for (int j = 0; j < 4; ++j) { const f32x4 w0 = ((const GAS f32x4*)final_w)[128 * j + 2 * F.lane], w1 = ((const GAS f32x4*)final_w)[128 * j + 2 * F.lane + 1];
                orow[128 * j + 2 * F.lane] = (f32x4){v[j][0] * rs * w0.x, v[j][1] * rs * w0.y, v[j][2] * rs * w0.z, v[j][3] * rs * w0.w};
                orow[128 * j + 2 * F.lane + 1] = (f32x4){v[j][4] * rs * w1.x, v[j][5] * rs * w1.y, v[j][6] * rs * w1.z, v[j][7] * rs * w1.w}; }
        }
    }
}

__global__ void __launch_bounds__(NWAVES * 64, 2) hybrid_fwd(Args args) {
    extern __shared__ __attribute__((aligned(16))) unsigned char lds[];
    Frame F;
    F.lds = (LAS unsigned char*)lds;
    volatile LAS unsigned* MISC = (volatile LAS unsigned*)(F.lds + MISC_OFF);
    for (int u = threadIdx.x; u < (LDS_BYTES - LDSCTL_OFF) / 4; u += NWAVES * 64) ((LAS unsigned*)(F.lds + LDSCTL_OFF))[u] = 0u;
    __syncthreads();
    XcdBarrier bar; bar.bar = (unsigned*)(args.ws + WS_CTL) + CW_BAR; bar.x = 0; bar.st = nullptr;
    if (!MK_PER_PHASE) bar = xcd_barrier_post((unsigned*)(args.ws + WS_CTL) + CW_BAR, MISC + 8);
    const int lo = args.ph_lo, hi = args.ph_hi;
#ifndef PH_MASK
#define PH_MASK 0x3f
#endif
#define IN(k) (lo <= (k) && (k) < hi)
#define EN(b) ((PH_MASK >> (b)) & 1)
#ifndef REP_MASK
#define REP_MASK 0
#endif
#define NREP(b) (((REP_MASK >> (b)) & 1) + 1)
#define SEAM(k) do { if (IN(k) && IN((k) + 1)) xcd_barrier(bar); } while (0)

    if (EN(0) && IN(0)) { for (int rep = 0; rep < NREP(0); ++rep) { if (rep) xcd_barrier(bar); frame_ids(F); p0_prologue(F); } } SEAM(0);
    for (int layer = 0; layer < DEPTH; ++layer) {
        const int pb = 1 + 3 * layer;
        if (EN(1) && IN(pb)) for (int rep = 0; rep < NREP(1); ++rep) {
            if (rep) xcd_barrier(bar);
            unsigned char* const ws = kargs()->ws;
            pg8::Gemm g{(const pg8::bf16_t*)(ws + WS_XB), (const pg8::bf16_t*)(ws + WS_WIN) + (size_t)layer * NPROJ * D, M, NPROJ, D};
            pg8::StaticOrder S; S.init(M, NPROJ, (int)gridDim.x, (int)blockIdx.x);
            pg8::EpiProj E{(pg8::bf16_t*)(ws + WS_PROJ), (const float*)(ws + (layer == 0 ? WS_SSQ0 : WS_SSQ1)), (const float*)(ws + WS_ROPE)};
            pg8::gemm_phase<pg8::EpiProj, pg8::StaticOrder, PG8_ALIGN, PG8_SP2>(F.lds + RING_OFF, g, S, E);
            if (TAIL_COPIES && rep == 0) {
                const int G_ = (int)gridDim.x, nwg = (M / 256) * (NPROJ / 256), full = nwg % G_;
                if (full != 0 && (int)blockIdx.x >= full) { frame_ids(F); const int w = ((int)blockIdx.x - full) * NWAVES + F.wave, nw = (G_ - full) * NWAVES;
                    if (layer == 0) weight_items(F, I_IN, I_LAYER + I_IN, w, nw); else weight_items(F, I_LAYER + I_IN, 2 * I_LAYER, w, nw); }
                else if (full == 0 && layer == 0) { frame_ids(F); weight_items(F, I_IN, 2 * I_LAYER, F.vcu * NWAVES + F.wave, F.G * NWAVES); }
            }
        }
        SEAM(pb);
        if (IN(pb + 1)) for (int rep = 0; rep < NREP(2) + NREP(3) - 1; ++rep) {
            if (rep) xcd_barrier(bar);
            frame_ids(F); const bool mix_first = (F.vcu & 1) == 0;
            for (int st = 0; st < 2; ++st) {
                if ((st == 0) == mix_first) { if (EN(3) && (rep == 0 || NREP(3) == 2)) { frame_ids(F); mix_phase(F, layer); } }
                else if (EN(2) && (rep == 0 || NREP(2) == 2)) {
                    KArgs ka = kargs(); unsigned char* const ws = ka->ws; frame_ids(F);
                    const float lam_init = 0.8f - 0.6f * __expf(-0.3f * (float)layer), lam = lam_of(ka, layer, F.lane);
                    const attn2::AttnTensors AT{(const attn2::bf16*)(ws + WS_PROJ), (attn2::bf16*)(ws + WS_MIX)};
                    attn2::attn_phase((char*)lds + RING_OFF, AT, F.vcu, lam, ka->in[I_SUBLN] + layer * 128, 1.0f - lam_init);
                }
            }
        }
        SEAM(pb + 1);
        if (EN(4) && IN(pb + 2)) for (int rep = 0; rep < (layer == 0 ? NREP(4) : 1); ++rep) {
            if (rep) xcd_barrier(bar);
            KArgs ka = kargs(); unsigned char* const ws = ka->ws; const float* xin = ka->in[I_X];
            pg8::Gemm g{(const pg8::bf16_t*)(ws + WS_MIX), (const pg8::bf16_t*)(ws + WS_WOUT) + (size_t)layer * D * D, M, D, D};
            pg8::StaticOrder S; S.init(M, D, (int)gridDim.x, (int)blockIdx.x);
            pg8::EpiResid E{layer == 0 ? xin : nullptr, layer == 0 ? nullptr : (const pg8::bf16_t*)(ws + WS_XB), (pg8::bf16_t*)(ws + WS_XB), (layer == 0 && rep == 0) ? (float*)(ws + WS_SSQ1) : nullptr};
            pg8::gemm_phase<pg8::EpiResid, pg8::StaticOrder, PG8_ALIGN, PG8_SP2>(F.lds + RING_OFF, g, S, E);
        }
        SEAM(pb + 2);
    }
    if (EN(5) && IN(7)) { frame_ids(F); final_norm(F); }
#undef IN
#undef SEAM
}

extern "C" void kernel_launch(void* const* d_in, const int* in_sizes, int n_in, void* d_out, int out_size, void* d_ws, size_t ws_size, hipStream_t stream) {
    static int grid = 0;
    if (grid == 0) {
        if (n_in != 15 || in_sizes[0] != M * D || out_size != M * D || ws_size < WS_END) { fprintf(stderr, "kernel_launch: shape/workspace mismatch (n_in %d, in0 %d, out %d, ws %zu); nothing launched\n", n_in, n_in > 0 ? in_sizes[0] : -1, out_size, ws_size); grid = -1; return; }
        int dev = 0, cus = 0, per_cu = 0;
        if (hipGetDevice(&dev) != hipSuccess || hipDeviceGetAttribute(&cus, hipDeviceAttributeMultiprocessorCount, dev) != hipSuccess) { grid = -1; return; }
        if (hipFuncSetAttribute((const void*)hybrid_fwd, hipFuncAttributeMaxDynamicSharedMemorySize, LDS_BYTES) != hipSuccess) { fprintf(stderr, "kernel_launch: hipFuncSetAttribute failed\n"); grid = -1; return; }
        if (hipOccupancyMaxActiveBlocksPerMultiprocessor(&per_cu, (const void*)hybrid_fwd, NWAVES * 64, LDS_BYTES) != hipSuccess || per_cu < 1)
            fprintf(stderr, "kernel_launch: note: occupancy query reports %d workgroups per CU\n", per_cu);
        (void)hipGetLastError();
        grid = cus;
    }
    if (grid < 0) return;
    if (hipMemsetAsync((char*)d_ws + WS_CTL, 0, CTL_ZERO_BYTES, stream) != hipSuccess) { fprintf(stderr, "kernel_launch: hipMemsetAsync failed\n"); return; }
    Args a{};
    for (int i = 0; i < 15; ++i) a.in[i] = (const float*)d_in[i];
    a.out = (float*)d_out; a.ws = (unsigned char*)d_ws;
#if MK_PER_PHASE
    for (int p = 0; p < NPHASE; ++p) { a.ph_lo = p; a.ph_hi = p + 1; hipLaunchKernelGGL(hybrid_fwd, dim3(grid), dim3(NWAVES * 64), LDS_BYTES, stream, a); }
#else
    a.ph_lo = 0; a.ph_hi = NPHASE;
    hipLaunchKernelGGL(hybrid_fwd, dim3(grid), dim3(NWAVES * 64), LDS_BYTES, stream, a);
#endif
    const hipError_t le = hipPeekAtLastError();
    if (le != hipSuccess) fprintf(stderr, "kernel_launch: launch failed: %s\n", hipGetErrorName(le));
}
```

```cpp
#include <hip/hip_runtime.h>
#include <cstdio>
#include <cstdint>
namespace pg8 {
#define PG8_LAS __attribute__((address_space(3)))
typedef unsigned short bf16_t;
typedef short bf16x8 __attribute__((ext_vector_type(8)));
typedef float f32x4 __attribute__((ext_vector_type(4)));
typedef unsigned u32x4 __attribute__((ext_vector_type(4)));
constexpr int BM = 256, BK = 64, HALF = 128, HTB = HALF * BK * 2  , STAGE_BYTES = 8 * HTB, NXCD = 8, WGM = 8;

__host__ __device__ __forceinline__ int lds_byte(int r, int c) { const int st = (r >> 4) * 2 + (c >> 5), rr = r & 15, cc = c & 31, ob = rr * 64 + cc * 2; return st * 1024 + (ob ^ (((ob >> 9) & 1) << 5)); }
__host__ __device__ __forceinline__ void stage_rc(int b, int& R, int& C) { const int st = b / 1024, sb = b % 1024, swz = sb ^ (((sb >> 9) & 1) << 5); R = (st >> 1) * 16 + swz / 64; C = (st & 1) * 32 + (swz % 64) / 2; }
__host__ __device__ __forceinline__ int perm32(int rho) { const int n = rho >> 4, i = rho & 15; return 8 * (i >> 2) + 4 * n + (i & 3); }

struct Unit { int pm, pn, seq; };
#ifndef GEMM_DBG
#define GEMM_DBG 0
#endif
struct Gemm { const bf16_t* A; const bf16_t* Bt; int M, N, K; unsigned long long* dbg; };

struct StaticOrder {
    int nM, nN, nwg, G, c, wv;
    __host__ __device__ void init(int M, int N, int G_, int c_) { nM = M / BM; nN = N / BM; nwg = nM * nN; G = G_; c = c_; }
    __host__ __device__ bool next(int i, Unit& u) const {
        const long L = (long)i * G + c; if (L >= nwg) return false;
        int wgid = (int)L; { const int q = nwg / NXCD, r = nwg % NXCD, xcd = wgid % NXCD, off = wgid / NXCD; wgid = (xcd < r ? xcd * (q + 1) : r * (q + 1) + (xcd - r) * q) + off; }
        const int nig = WGM * nN, gid = wgid / nig, fm = gid * WGM, gsz = (nM - fm) < WGM ? (nM - fm) : WGM;
        u.pm = fm + ((wgid % nig) % gsz); u.pn = (wgid % nig) / gsz; return true;
    }
    __device__ __forceinline__ void a_ready(const Unit&) const {}
    __device__ __forceinline__ void done(const Unit&) const {}
};

__device__ __forceinline__ int pg8_lane() { int l; asm volatile("v_mbcnt_lo_u32_b32 %0, -1, 0\n\tv_mbcnt_hi_u32_b32 %0, -1, %0" : "=v"(l)); return l; }
__device__ __forceinline__ float add_xor16(float v) { return v + __int_as_float(__builtin_amdgcn_ds_swizzle(__float_as_int(v), 0x401F)); }
__device__ __forceinline__ float add_xor32(float v) { auto rr = __builtin_amdgcn_permlane32_swap(__float_as_uint(v), __float_as_uint(v), false, false); return __uint_as_float(rr[0]) + __uint_as_float(rr[1]); }
__device__ __forceinline__ unsigned cvt_pk_bf16(float lo, float hi) { unsigned r; asm volatile("v_cvt_pk_bf16_f32 %0, %1, %2" : "=v"(r) : "v"(lo), "v"(hi)); return r; }
typedef float f32x2 __attribute__((ext_vector_type(2)));
constexpr float QK_C2 = 0.125f * 1.4426950408889634f;
constexpr int PROJ_LD = 7680, DMODEL = 2048;
__device__ __forceinline__ float silu_f(float v) { return v * __builtin_amdgcn_rcpf(1.0f + __builtin_amdgcn_exp2f(-1.4426950408889634f * v)); }
struct EpiProj {
    static constexpr bool PERM = true, AFTER_DRAIN = false, PREFETCH = true;
    bf16_t* O; const float* ssq; float* lns; PG8_LAS float* side;
    __device__ __forceinline__ void prefetch(const Unit& u, int wid, int lane) const {
        if (wid < 4) __builtin_amdgcn_global_load_lds((const unsigned*)(ssq + u.pm * BM + wid * 64 + lane), (PG8_LAS unsigned*)(side + (u.seq & 1) * 256 + wid * 64), 4, 0, 0);
    }
    __device__ __forceinline__ void operator()(const f32x4 (&acc)[2][2][4][2], const Unit& u, int wr, int wc, int fr, int fq) const {
        const int row0 = u.pm * BM + wr * 64 + fr, col0 = u.pn * BM + wc * 32 + 8 * fq, pn = u.pn;
        const int mode = (pn < 8) ? 1 : ((pn >= 12 && pn < 16) ? 2 : ((pn >= 16 && pn != 18 && pn != 19) ? 3 : 0));
        const bool pair_silu = !(pn == 22 || pn == 23 || pn == 26 || pn == 27);
        const int pair_col = (pn <= 21 ? 4096 + ((pn == 16 || pn == 17) ? (pn - 16) : (pn - 18)) * 128
                              : (pn == 22 || pn == 23 || pn == 26 || pn == 27) ? 5632 + ((pn < 24) ? (pn - 22) : (pn - 24)) * 128
                              : 6144 + ((pn < 26) ? (pn - 24) : (pn - 26)) * 128) + 16 * wc + 4 * fq;
        const float qs = (pn < 4) ? QK_C2 : 1.0f;
        const PG8_LAS float* sq = side + (u.seq & 1) * 256 + wr * 64 + fr;
        float ci[4], c128[4];
#pragma unroll
        for (int e = 0; e < 4; ++e) { const int i = 4 * (4 * (wc & 1) + fq) + e; ci[e] = __builtin_amdgcn_exp2f(-0.41524101186092029f * (float)i) * 0.15915494309189535f; c128[e] = __builtin_amdgcn_fractf(128.0f * ci[e]); }
#pragma unroll
        for (int ai = 0; ai < 2; ++ai)
#pragma unroll
            for (int m = 0; m < 4; ++m) {
                const int row = row0 + ai * HALF + m * 16;
                const float rs = __builtin_amdgcn_rsqf(sq[ai * HALF + m * 16] * (1.0f / 2048.0f) + 1e-5f);
                bf16_t* rowp = O + (size_t)row * PROJ_LD + col0;
                if (mode == 1) {
                    const int p = row & 4095; const float ph = (float)(p >> 7), pl = (float)(p & 127);
                    f32x4 c4, s4;
#pragma unroll
                    for (int e = 0; e < 4; ++e) { const float rev = __builtin_amdgcn_fractf(ph * c128[e] + pl * ci[e]); c4[e] = __builtin_amdgcn_cosf(rev); s4[e] = __builtin_amdgcn_sinf(rev); }
                    const float sc = rs * qs;
#pragma unroll
                    for (int bj = 0; bj < 2; ++bj) { const f32x4 v0 = acc[ai][bj][m][0] * sc, v1 = acc[ai][bj][m][1] * sc;
                        const f32x4 o0 = v0 * c4 - v1 * s4, o1 = v1 * c4 + v0 * s4;
                        u32x4 w; w.x = cvt_pk_bf16(o0[0], o0[1]); w.y = cvt_pk_bf16(o0[2], o0[3]); w.z = cvt_pk_bf16(o1[0], o1[1]); w.w = cvt_pk_bf16(o1[2], o1[3]);
                        *(u32x4*)(rowp + bj * HALF) = w; }
                } else if (mode == 3) {
#pragma unroll
                    for (int bj = 0; bj < 2; ++bj) { const f32x4 va = acc[ai][bj][m][0] * rs; f32x4 vb = acc[ai][bj][m][1] * rs;
                        if (pair_silu) {
#pragma unroll
                            for (int j = 0; j < 4; ++j) vb[j] = silu_f(vb[j]); }
                        const f32x4 pr = va * vb; uint2 w; w.x = cvt_pk_bf16(pr[0], pr[1]); w.y = cvt_pk_bf16(pr[2], pr[3]);
                        *(uint2*)(O + (size_t)row * PROJ_LD + pair_col + 64 * bj) = w; }
                } else if (mode == 2) {
#pragma unroll
                    for (int bj = 0; bj < 2; ++bj) { f32x4 v0 = acc[ai][bj][m][0] * rs, v1 = acc[ai][bj][m][1] * rs;
#pragma unroll
                        for (int j = 0; j < 4; ++j) { v0[j] = silu_f(v0[j]); v1[j] = silu_f(v1[j]); }
                        u32x4 w; w.x = cvt_pk_bf16(v0[0], v0[1]); w.y = cvt_pk_bf16(v0[2], v0[3]); w.z = cvt_pk_bf16(v1[0], v1[1]); w.w = cvt_pk_bf16(v1[2], v1[3]);
                        *(u32x4*)(rowp + bj * HALF) = w; }
                } else {
                    float s1 = 0.f, s2 = 0.f;
#pragma unroll
                    for (int bj = 0; bj < 2; ++bj) { const f32x4 v0 = acc[ai][bj][m][0] * rs, v1 = acc[ai][bj][m][1] * rs;
                        u32x4 w; w.x = cvt_pk_bf16(v0[0], v0[1]); w.y = cvt_pk_bf16(v0[2], v0[3]); w.z = cvt_pk_bf16(v1[0], v1[1]); w.w = cvt_pk_bf16(v1[2], v1[3]);
                        *(u32x4*)(rowp + bj * HALF) = w;
                        s1 += ((v0[0] + v0[1]) + (v0[2] + v0[3])) + ((v1[0] + v1[1]) + (v1[2] + v1[3]));
                        s2 += ((v0[0] * v0[0] + v0[1] * v0[1]) + (v0[2] * v0[2] + v0[3] * v0[3])) + ((v1[0] * v1[0] + v1[1] * v1[1]) + (v1[2] * v1[2] + v1[3] * v1[3])); }
                    if (pn == 18 || pn == 19) {
                        s1 = add_xor32(add_xor16(s1)); s2 = add_xor32(add_xor16(s2));
                        if (fq == 0) { atomicAdd(lns + 2 * row, s1); atomicAdd(lns + 2 * row + 1, s2); } }
                }
            }
    }
};
struct EpiResid {
    static constexpr bool PERM = true, AFTER_DRAIN = false, PREFETCH = false;
    const float* base32; const bf16_t* base16; bf16_t* xb; float* ssq;
    __device__ __forceinline__ void operator()(const f32x4 (&acc)[2][2][4][2], const Unit& u, int wr, int wc, int fr, int fq) const {
        const int row0 = u.pm * BM + wr * 64 + fr, col0 = u.pn * BM + wc * 32 + 8 * fq;
#pragma unroll
        for (int ai = 0; ai < 2; ++ai) {
            f32x4 b[4][2][2];
            if (base32) {
#pragma unroll
                for (int m = 0; m < 4; ++m) { const size_t off = (size_t)(row0 + ai * HALF + m * 16) * DMODEL + col0;
#pragma unroll
                    for (int bj = 0; bj < 2; ++bj) { b[m][bj][0] = *(const f32x4*)(base32 + off + bj * HALF); b[m][bj][1] = *(const f32x4*)(base32 + off + bj * HALF + 4); } }
            } else {
                u32x4 bw[4][2];
#pragma unroll
                for (int m = 0; m < 4; ++m) { const size_t off = (size_t)(row0 + ai * HALF + m * 16) * DMODEL + col0;
#pragma unroll
                    for (int bj = 0; bj < 2; ++bj) bw[m][bj] = *(const u32x4*)(base16 + off + bj * HALF); }
#pragma unroll
                for (int m = 0; m < 4; ++m)
#pragma unroll
                    for (int bj = 0; bj < 2; ++bj) { const u32x4 w = bw[m][bj];
                        b[m][bj][0] = (f32x4){__uint_as_float(w.x << 16), __uint_as_float(w.x & 0xffff0000u), __uint_as_float(w.y << 16), __uint_as_float(w.y & 0xffff0000u)};
                        b[m][bj][1] = (f32x4){__uint_as_float(w.z << 16), __uint_as_float(w.z & 0xffff0000u), __uint_as_float(w.w << 16), __uint_as_float(w.w & 0xffff0000u)}; }
            }
#pragma unroll
            for (int m = 0; m < 4; ++m) {
                const int row = row0 + ai * HALF + m * 16; const size_t off = (size_t)row * DMODEL + col0;
                float part = 0.f;
#pragma unroll
                for (int bj = 0; bj < 2; ++bj) { const f32x4 x0 = b[m][bj][0] + acc[ai][bj][m][0], x1 = b[m][bj][1] + acc[ai][bj][m][1];
                    u32x4 w; w.x = cvt_pk_bf16(x0[0], x0[1]); w.y = cvt_pk_bf16(x0[2], x0[3]); w.z = cvt_pk_bf16(x1[0], x1[1]); w.w = cvt_pk_bf16(x1[2], x1[3]); *(u32x4*)(xb + off + bj * HALF) = w;
                    part += (x0[0] * x0[0] + x0[1] * x0[1]) + (x0[2] * x0[2] + x0[3] * x0[3]) + (x1[0] * x1[0] + x1[1] * x1[1]) + (x1[2] * x1[2] + x1[3] * x1[3]); }
                if (ssq) { part = add_xor32(add_xor16(part)); if (fq == 0) atomicAdd(ssq + row, part); }
            }
        }
    }
};

struct PanelOrder {
    int vcu, G, wv;
    __device__ __forceinline__ bool next(int i, Unit& u) const { if (i >= 2 || G != 256) return false; u.pm = 32 * i + (vcu >> 3); u.pn = vcu & 7; u.seq = 0; return true; }
    __device__ __forceinline__ void a_ready(const Unit&) const {}
    __device__ __forceinline__ void done(const Unit&) const {}
};
struct EpiFinal {
    static constexpr bool PERM = true, AFTER_DRAIN = false, PREFETCH = false;
    const bf16_t* base16; float* out; const float* fw; float* ssq; unsigned* cnt;
    __device__ __forceinline__ void operator()(const f32x4 (&acc_)[2][2][4][2], const Unit& u, int wr, int wc, int fr, int fq) const {
        f32x4 (&acc)[2][2][4][2] = const_cast<f32x4 (&)[2][2][4][2]>(acc_);
        const int row0 = u.pm * BM + wr * 64 + fr, col0 = u.pn * BM + wc * 32 + 8 * fq;
        f32x4 wv[2][2];
#pragma unroll
        for (int bj = 0; bj < 2; ++bj) { wv[bj][0] = *(const f32x4*)(fw + col0 + bj * HALF); wv[bj][1] = *(const f32x4*)(fw + col0 + bj * HALF + 4); }
#pragma unroll
        for (int ai = 0; ai < 2; ++ai) {
            u32x4 bw[4][2];
#pragma unroll
            for (int m = 0; m < 4; ++m) { const size_t off = (size_t)(row0 + ai * HALF + m * 16) * DMODEL + col0;
#pragma unroll
                for (int bj = 0; bj < 2; ++bj) bw[m][bj] = *(const u32x4*)(base16 + off + bj * HALF); }
#pragma unroll
            for (int m = 0; m < 4; ++m) { float part = 0.f;
#pragma unroll
                for (int bj = 0; bj < 2; ++bj) { const u32x4 w = bw[m][bj];
                    const f32x4 b0 = (f32x4){__uint_as_float(w.x << 16), __uint_as_float(w.x & 0xffff0000u), __uint_as_float(w.y << 16), __uint_as_float(w.y & 0xffff0000u)};
                    const f32x4 b1 = (f32x4){__uint_as_float(w.z << 16), __uint_as_float(w.z & 0xffff0000u), __uint_as_float(w.w << 16), __uint_as_float(w.w & 0xffff0000u)};
                    const f32x4 x0 = b0 + acc[ai][bj][m][0], x1 = b1 + acc[ai][bj][m][1]; acc[ai][bj][m][0] = x0; acc[ai][bj][m][1] = x1;
                    part += (x0[0] * x0[0] + x0[1] * x0[1]) + (x0[2] * x0[2] + x0[3] * x0[3]) + (x1[0] * x1[0] + x1[1] * x1[1]) + (x1[2] * x1[2] + x1[3] * x1[3]); }
                part = add_xor32(add_xor16(part));
                if (fq == 0) atomicAdd(ssq + row0 + ai * HALF + m * 16, part); }
        }
        asm volatile("s_waitcnt vmcnt(0)" ::: "memory");
        unsigned* c = cnt + 64 * u.pm;
        if (pg8_lane() == 0) __hip_atomic_fetch_add(c, 1u, __ATOMIC_RELAXED, __HIP_MEMORY_SCOPE_AGENT);
        { unsigned spins = 0;
          while ((unsigned)__builtin_amdgcn_readfirstlane(__hip_atomic_load(c, __ATOMIC_RELAXED, __HIP_MEMORY_SCOPE_AGENT)) < 64u) { __builtin_amdgcn_s_sleep(2); if (++spins > (1u << 22)) break; } }
        asm volatile("" ::: "memory");
        float ssv[2][4];
#pragma unroll
        for (int ai = 0; ai < 2; ++ai)
#pragma unroll
            for (int m = 0; m < 4; ++m) ssv[ai][m] = __hip_atomic_load(ssq + row0 + ai * HALF + m * 16, __ATOMIC_RELAXED, __HIP_MEMORY_SCOPE_AGENT);
#pragma unroll
        for (int ai = 0; ai < 2; ++ai)
#pragma unroll
            for (int m = 0; m < 4; ++m) { const int row = row0 + ai * HALF + m * 16;
                const float ss = ssv[ai][m];
                const float rs = __builtin_amdgcn_rsqf(ss * (1.0f / 2048.0f) + 1e-5f); float* rowp = out + (size_t)row * DMODEL + col0;
#pragma unroll
                for (int bj = 0; bj < 2; ++bj) { *(f32x4*)(rowp + bj * HALF) = acc[ai][bj][m][0] * rs * wv[bj][0]; *(f32x4*)(rowp + bj * HALF + 4) = acc[ai][bj][m][1] * rs * wv[bj][1]; } }
    }
};


template <class Epi, class Sched, bool ALIGN_EPI = false, bool SP2 = false>
__device__ __forceinline__ void gemm_phase(PG8_LAS unsigned char* lds, const Gemm g, const Sched& S, const Epi& E) {
    int tid_ = S.wv * 64 + pg8_lane(); asm volatile("" : "+v"(tid_));
    const int tid = tid_, wid = __builtin_amdgcn_readfirstlane(tid >> 6), lane = tid & 63, wr = wid >> 2, wc = wid & 3, fr = lane & 15, fq = lane >> 4;
    const int K = g.K, nt = K / BK;
    unsigned voffA[2], voffB[2];
#pragma unroll
    for (int i = 0; i < 2; ++i) { int R, C; stage_rc(tid * 16 + i * 8192, R, C); const int Rb = Epi::PERM ? ((R & ~31) + perm32(R & 31)) : R;
        voffA[i] = (unsigned)(R * K + C) * 2u; voffB[i] = (unsigned)(Rb * K + C) * 2u; }
    const size_t kstep = (size_t)(BK * 2);
    const size_t hstep = (size_t)HALF * K * 2;
    const size_t tstep = 2 * hstep;
    const unsigned ldsw = (unsigned)wid * 1024u;
    const int aoff = lds_byte(wr * 64 + fr, fq * 8), boff = lds_byte(wc * 32 + fr, fq * 8);
#define PG8_SA(b, h) (((b) * 2 + (h)) * HTB)
#define PG8_SB(b, h) ((4 + (b) * 2 + (h)) * HTB)
#define PG8_STAGE(bufoff, gbase, voff) do { _Pragma("unroll") for (int _i = 0; _i < 2; ++_i) \
        __builtin_amdgcn_global_load_lds((const unsigned*)((const char*)(gbase) + (voff)[_i]), (PG8_LAS unsigned*)(lds + (bufoff) + ldsw + _i * 8192), 16, 0, 0); } while (0)
#define PG8_LDA(dst, b, h) do { _Pragma("unroll") for (int m = 0; m < 4; ++m) _Pragma("unroll") for (int k = 0; k < 2; ++k) dst[m][k] = *(const PG8_LAS bf16x8*)(lds + PG8_SA(b, h) + aoff + m * 2048 + k * 1024); } while (0)
#define PG8_LDB(dst, b, h) do { _Pragma("unroll") for (int n = 0; n < 2; ++n) _Pragma("unroll") for (int k = 0; k < 2; ++k) dst[n][k] = *(const PG8_LAS bf16x8*)(lds + PG8_SB(b, h) + boff + n * 2048 + k * 1024); } while (0)
#define PG8_MMA(ai, bj, At, Bt) do { __builtin_amdgcn_s_setprio(1); _Pragma("unroll") for (int m = 0; m < 4; ++m) _Pragma("unroll") for (int n = 0; n < 2; ++n) _Pragma("unroll") for (int k = 0; k < 2; ++k) \
        acc[ai][bj][m][n] = __builtin_amdgcn_mfma_f32_16x16x32_bf16(Bt[n][k], At[m][k], acc[ai][bj][m][n], 0, 0, 0); __builtin_amdgcn_s_setprio(0); } while (0)
#define PG8_WAIT_V(n) asm volatile("s_waitcnt vmcnt(" #n ")" ::: "memory")
#define PG8_WAIT_L(n) asm volatile("s_waitcnt lgkmcnt(" #n ")" ::: "memory")
#define PG8_BAR __builtin_amdgcn_s_barrier()
#define PG8_SCHED __builtin_amdgcn_sched_barrier(0)
#if GEMM_DBG
    unsigned long long gemm_dbg_epi = 0; const unsigned long long tg0_ = __builtin_amdgcn_s_memtime();
#endif
    Unit cur, nxt; int ui = 0;
    if (!S.next(0, cur)) return;
    cur.seq = 0; if constexpr (Epi::PREFETCH) E.prefetch(cur, wid, lane);
    f32x4 acc[2][2][4][2];
#pragma unroll
    for (int a = 0; a < 2; ++a)
#pragma unroll
        for (int b = 0; b < 2; ++b)
#pragma unroll
            for (int m = 0; m < 4; ++m)
#pragma unroll
                for (int n = 0; n < 2; ++n) acc[a][b][m][n] = (f32x4){0.f, 0.f, 0.f, 0.f};
    bf16x8 At[4][2], B0[2][2], B1[2][2];
    const char* cA = (const char*)g.A + (size_t)cur.pm * tstep; const char* cB = (const char*)g.Bt + (size_t)cur.pn * tstep;
    S.a_ready(cur);
    if constexpr (SP2) {
        PG8_STAGE(PG8_SB(0, 0), cB, voffB); PG8_STAGE(PG8_SB(0, 1), cB + hstep, voffB); PG8_STAGE(PG8_SA(0, 0), cA, voffA); PG8_STAGE(PG8_SA(0, 1), cA + hstep, voffA);
        if (wr == 1) PG8_BAR;
        PG8_WAIT_V(2); PG8_BAR;
        PG8_STAGE(PG8_SB(1, 0), cB + kstep, voffB); PG8_STAGE(PG8_SA(1, 0), cA + kstep, voffA); PG8_STAGE(PG8_SB(1, 1), cB + hstep + kstep, voffB);
        PG8_WAIT_V(6); PG8_BAR;
    } else {
        PG8_STAGE(PG8_SB(0, 0), cB, voffB); PG8_STAGE(PG8_SA(0, 0), cA, voffA); PG8_STAGE(PG8_SB(0, 1), cB + hstep, voffB); PG8_STAGE(PG8_SA(0, 1), cA + hstep, voffA);
        if (wr == 1) PG8_BAR;
        PG8_WAIT_V(4); PG8_BAR;
        PG8_STAGE(PG8_SB(1, 0), cB + kstep, voffB); PG8_STAGE(PG8_SA(1, 0), cA + kstep, voffA); PG8_STAGE(PG8_SB(1, 1), cB + hstep + kstep, voffB);
        PG8_WAIT_V(6); PG8_BAR;
    }
    for (;;) {
        const bool has_next = S.next(ui + 1, nxt); nxt.seq = ui + 1;
        const char* nA = has_next ? (const char*)g.A + (size_t)nxt.pm * tstep : cA; const char* nB = has_next ? (const char*)g.Bt + (size_t)nxt.pn * tstep : cB;
        for (int t = 0; t < nt; t += 2) {
            const bool last = (t == nt - 2);
            const char* a1 = cA + (size_t)(t + 1) * kstep;
            const char* a2 = last ? nA : cA + (size_t)(t + 2) * kstep; const char* b2 = last ? nB : cB + (size_t)(t + 2) * kstep;
            const char* a3 = a2 + kstep; const char* b3 = b2 + kstep;
            if (last && has_next) { S.a_ready(nxt); if constexpr (Epi::PREFETCH) E.prefetch(nxt, wid, lane); }
            if constexpr (SP2) {
            PG8_LDB(B0, 0, 0); PG8_LDB(B1, 0, 1); PG8_SCHED; PG8_LDA(At, 0, 0); PG8_STAGE(PG8_SA(1, 1), a1 + hstep, voffA);
            PG8_WAIT_V(8); PG8_WAIT_L(0); PG8_BAR; PG8_MMA(0, 0, At, B0); PG8_MMA(0, 1, At, B1); PG8_BAR; PG8_SCHED;
            PG8_LDA(At, 0, 1); PG8_STAGE(PG8_SB(0, 0), b2, voffB); PG8_STAGE(PG8_SB(0, 1), b2 + hstep, voffB); PG8_STAGE(PG8_SA(0, 0), a2, voffA);
            PG8_WAIT_V(8); PG8_WAIT_L(0); PG8_BAR; PG8_MMA(1, 0, At, B0); PG8_MMA(1, 1, At, B1); PG8_BAR; PG8_SCHED;
            PG8_LDB(B0, 1, 0); PG8_LDB(B1, 1, 1); PG8_SCHED; PG8_LDA(At, 1, 0); PG8_STAGE(PG8_SA(0, 1), a2 + hstep, voffA);
            PG8_WAIT_V(8); PG8_WAIT_L(0); PG8_BAR; PG8_MMA(0, 0, At, B0); PG8_MMA(0, 1, At, B1); PG8_BAR; PG8_SCHED;
            PG8_LDA(At, 1, 1); PG8_STAGE(PG8_SB(1, 0), b3, voffB); PG8_STAGE(PG8_SB(1, 1), b3 + hstep, voffB); PG8_STAGE(PG8_SA(1, 0), a3, voffA);
            PG8_WAIT_V(8); PG8_WAIT_L(0); PG8_BAR; PG8_MMA(1, 0, At, B0); PG8_MMA(1, 1, At, B1); PG8_BAR; PG8_SCHED;
            } else {
            PG8_LDB(B0, 0, 0); PG8_SCHED; PG8_LDA(At, 0, 0); PG8_STAGE(PG8_SA(1, 1), a1 + hstep, voffA);
            PG8_WAIT_L(8); PG8_BAR; PG8_WAIT_L(0); PG8_MMA(0, 0, At, B0); PG8_BAR; PG8_SCHED;
            PG8_LDB(B1, 0, 1); PG8_STAGE(PG8_SB(0, 0), b2, voffB);
            PG8_BAR; PG8_WAIT_L(0); PG8_MMA(0, 1, At, B1); PG8_BAR;
            PG8_LDA(At, 0, 1); PG8_STAGE(PG8_SA(0, 0), a2, voffA);
            PG8_BAR; PG8_WAIT_L(0); PG8_MMA(1, 0, At, B0); PG8_BAR; PG8_SCHED;
            PG8_STAGE(PG8_SB(0, 1), b2 + hstep, voffB);
            PG8_WAIT_V(6); PG8_BAR; PG8_MMA(1, 1, At, B1); PG8_BAR;
            PG8_LDB(B0, 1, 0); PG8_SCHED; PG8_LDA(At, 1, 0); PG8_STAGE(PG8_SA(0, 1), a2 + hstep, voffA);
            PG8_WAIT_L(8); PG8_BAR; PG8_WAIT_L(0); PG8_MMA(0, 0, At, B0); PG8_BAR; PG8_SCHED;
            PG8_LDB(B1, 1, 1); PG8_STAGE(PG8_SB(1, 0), b3, voffB);
            PG8_BAR; PG8_WAIT_L(0); PG8_MMA(0, 1, At, B1); PG8_BAR;
            PG8_LDA(At, 1, 1); PG8_STAGE(PG8_SA(1, 0), a3, voffA);
            PG8_BAR; PG8_WAIT_L(0); PG8_MMA(1, 0, At, B0); PG8_BAR; PG8_SCHED;
            PG8_STAGE(PG8_SB(1, 1), b3 + hstep, voffB);
            PG8_WAIT_V(6); PG8_BAR; PG8_MMA(1, 1, At, B1); PG8_BAR;
            }
        }
        if constexpr (ALIGN_EPI) { if (wr == 0) PG8_BAR; }
#if GEMM_DBG
        const unsigned long long te0_ = __builtin_amdgcn_s_memtime();
#endif
        if constexpr (!Epi::AFTER_DRAIN) { E(acc, cur, wr, wc, fr, fq); S.done(cur); }
#if GEMM_DBG
        asm volatile("s_waitcnt vmcnt(0)" ::: "memory"); gemm_dbg_epi += __builtin_amdgcn_s_memtime() - te0_;
#endif
        if (!has_next) break;
#pragma unroll
        for (int a = 0; a < 2; ++a)
#pragma unroll
            for (int b = 0; b < 2; ++b)
#pragma unroll
                for (int m = 0; m < 4; ++m)
#pragma unroll
                    for (int n = 0; n < 2; ++n) acc[a][b][m][n] = (f32x4){0.f, 0.f, 0.f, 0.f};
        cur = nxt; cA = nA; cB = nB; ++ui;
        if constexpr (ALIGN_EPI) { if (wr == 1) PG8_BAR; }
    }
#if GEMM_DBG
    if (g.dbg && blockIdx.x == 0 && tid == 0) { g.dbg[0] = __builtin_amdgcn_s_memtime() - tg0_; g.dbg[1] = gemm_dbg_epi; }
#endif
    PG8_WAIT_V(0);
    if constexpr (!ALIGN_EPI) { if (wr == 0) PG8_BAR; }
    PG8_BAR;
    if constexpr (Epi::AFTER_DRAIN) { E.fused(acc, cur, wr, wc, fr, fq, lds, wid, lane); S.done(cur); }
#undef PG8_SA
#undef PG8_SB
#undef PG8_STAGE
#undef PG8_LDA
#undef PG8_LDB
#undef PG8_MMA
#undef PG8_WAIT_V
#undef PG8_WAIT_L
#undef PG8_BAR
#undef PG8_SCHED
}
}
#ifndef PG8_SP2
#define PG8_SP2 true
#endif
#ifndef PG8_ALIGN
#define PG8_ALIGN true
#endif
namespace attn2 {
typedef unsigned short bf16;
typedef short bf16x8 __attribute__((ext_vector_type(8)));
typedef short s16x4 __attribute__((ext_vector_type(4)));
typedef float f32x16 __attribute__((ext_vector_type(16)));
typedef float f32x4 __attribute__((ext_vector_type(4)));
typedef unsigned u32x4 __attribute__((ext_vector_type(4)));
constexpr int NW = 8, QBLK = 32, KVBLK = 64, QB = NW * QBLK, DQ = 64, DV = 128, PQ = 7680, PO = 2048, SEQ = 4096, NQB = SEQ / QB;
constexpr int SHM_V = KVBLK * DV * 2, SHM_K = KVBLK * DQ * 2;
constexpr int LDS_WS = 2 * SHM_V + 2 * SHM_K, LDS_OST = LDS_WS + NW * 64 * 4, LDS_BYTES = LDS_OST + NW * QBLK * DV * 2;
constexpr float THR = 8.f;
#define A2_KSWZ(row, colB) ((row) * 128 + ((colB) ^ ((((row) >> 1) & 7) << 4)))
#define A2_SBAR() __builtin_amdgcn_sched_barrier(0)
__device__ __forceinline__ int v_st(int k, int c) { const int kk = k; return ((kk >> 3) * 4 + (c >> 5)) * 512 + ((kk & 7) * 32 + (c & 31)) * 2; }
__device__ __forceinline__ int v_rd_base(int lane) { return ((lane & 3) << 3) | (((lane >> 2) & 3) << 6) | (((lane >> 4) & 1) << 5) | (((lane >> 5) & 1) << 8); }
constexpr int v_rd_off(int d0, int ks, int half) { return d0 * 512 + ks * 4096 + half * 2048; }
__device__ __forceinline__ int crow(int r, int hi) { return (r & 3) + 8 * (r >> 2) + 4 * hi; }
__device__ __forceinline__ unsigned cvtpk(float lo, float hi) { unsigned r; asm volatile("v_cvt_pk_bf16_f32 %0, %1, %2" : "=v"(r) : "v"(lo), "v"(hi)); return r; }
__device__ __forceinline__ bf16x8 load8(const bf16* p) { return *reinterpret_cast<const bf16x8*>(p); }
__device__ __forceinline__ void mask_tile(f32x16& p0, f32x16& p1, int dq) {
    const float NEG = -__builtin_inff();
#pragma unroll
    for (int r = 0; r < 16; ++r) { const int c = (r & 3) + 8 * (r >> 2); if (dq - c < 0) p0[r] = NEG; if (dq - c - 32 < 0) p1[r] = NEG; }
}
__device__ __forceinline__ void softmax_tile(f32x16& p0, f32x16& p1, float& m_reg, f32x16& negm, f32x16 (&o)[4], float& l_reg, bool first, bf16x8& pa0, bf16x8& pa1, bf16x8& pa2, bf16x8& pa3) {
    float a = fmaxf(fmaxf(p0[0], p0[1]), p1[0]), b = fmaxf(fmaxf(p0[2], p0[3]), p1[1]);
#pragma unroll
    for (int r = 4; r < 16; r += 4) { a = fmaxf(fmaxf(a, p0[r]), p0[r + 1]); b = fmaxf(fmaxf(b, p0[r + 2]), p0[r + 3]); }
#pragma unroll
    for (int r = 2; r < 16; r += 2) { a = fmaxf(a, p1[r]); b = fmaxf(b, p1[r + 1]); }
    float pmax = fmaxf(a, b);
    if (__builtin_expect(first || !__all(pmax <= THR), 0)) {
        { auto rr = __builtin_amdgcn_permlane32_swap(__float_as_uint(pmax), __float_as_uint(pmax), false, false); pmax = fmaxf(__uint_as_float(rr[0]), __uint_as_float(rr[1])); }
        const float dl = first ? pmax : fmaxf(pmax, 0.f);
        m_reg += dl;
        if (!first) { const float alpha = __builtin_amdgcn_exp2f(-dl); l_reg *= alpha;
#pragma unroll
            for (int d_ = 0; d_ < 4; ++d_)
#pragma unroll
                for (int r = 0; r < 16; ++r) o[d_][r] *= alpha; }
#pragma unroll
        for (int r = 0; r < 16; ++r) { p0[r] -= dl; p1[r] -= dl; negm[r] -= dl; }
    }
#define A2_EXP(x) ({ float r_; asm volatile("v_exp_f32 %0, %1" : "=v"(r_) : "v"(x)); r_; })
#pragma unroll
    for (int r = 0; r < 16; ++r) p0[r] = A2_EXP(p0[r]);
#pragma unroll
    for (int r = 0; r < 16; ++r) p1[r] = A2_EXP(p1[r]);
#undef A2_EXP
#define A2_FADD(a, b) ({ float r_; asm volatile("v_add_f32 %0, %1, %2" : "=v"(r_) : "v"(a), "v"(b)); r_; })
    float s0 = A2_FADD(p0[0], p0[1]), s1 = A2_FADD(p0[2], p0[3]), s2 = A2_FADD(p1[0], p1[1]), s3 = A2_FADD(p1[2], p1[3]);
#pragma unroll
    for (int r = 4; r < 16; r += 4) { s0 = A2_FADD(s0, A2_FADD(p0[r], p0[r + 1])); s1 = A2_FADD(s1, A2_FADD(p0[r + 2], p0[r + 3])); s2 = A2_FADD(s2, A2_FADD(p1[r], p1[r + 1])); s3 = A2_FADD(s3, A2_FADD(p1[r + 2], p1[r + 3])); }
    const float ps = A2_FADD(A2_FADD(s0, s1), A2_FADD(s2, s3));
#undef A2_FADD
    l_reg += ps;
#define A2_PK4(P, B_, OUT) do { u32x4 w = {cvtpk(P[B_+0], P[B_+1]), cvtpk(P[B_+2], P[B_+3]), cvtpk(P[B_+4], P[B_+5]), cvtpk(P[B_+6], P[B_+7])}; OUT = *reinterpret_cast<bf16x8*>(&w); } while (0)
    A2_PK4(p0, 0, pa0); A2_PK4(p0, 8, pa1); A2_PK4(p1, 0, pa2); A2_PK4(p1, 8, pa3);
#undef A2_PK4
}
template <int KB> __device__ __forceinline__ void kload(bf16x8* kf, const char* K_lds, int r32, int hi) {
#pragma unroll
    for (int d0 = 0; d0 < 4; ++d0) { const char* a = K_lds + KB * SHM_K + A2_KSWZ(r32, (d0 * 16 + hi * 8) * 2);
        kf[2 * d0] = *reinterpret_cast<const bf16x8*>(a); kf[2 * d0 + 1] = *reinterpret_cast<const bf16x8*>(a + 32 * 128); }
}
__device__ __forceinline__ void qkt(f32x16& p0, f32x16& p1, const bf16x8* kf, const bf16x8* qr, const f32x16& negm) {
    p0 = negm; p1 = negm;
#pragma unroll
    for (int d0 = 0; d0 < 4; ++d0) { p0 = __builtin_amdgcn_mfma_f32_32x32x16_bf16(kf[2 * d0], qr[d0], p0, 0, 0, 0); p1 = __builtin_amdgcn_mfma_f32_32x32x16_bf16(kf[2 * d0 + 1], qr[d0], p1, 0, 0, 0); }
}
#define A2_TRRD(dst, off) asm volatile("ds_read_b64_tr_b16 %0, %1 offset:%2" : "=&v"(dst) : "v"(vb0), "i"(off) : "memory")
#define PV_RD0(VB) do { constexpr int b_ = (VB) * SHM_V + v_rd_off(0, 0, 0); A2_TRRD(al0, b_); A2_TRRD(ah0, b_ + 2048); A2_TRRD(al1, b_ + 4096); A2_TRRD(ah1, b_ + 6144); A2_TRRD(al2, b_ + 8192); A2_TRRD(ah2, b_ + 10240); A2_TRRD(al3, b_ + 12288); A2_TRRD(ah3, b_ + 14336); } while (0)
#define A2_PV_D0(VB, d0) do { s16x4 l0, l1, l2, l3, h0, h1, h2, h3; constexpr int b_ = (VB) * SHM_V + v_rd_off(d0, 0, 0); \
        A2_TRRD(l0, b_); A2_TRRD(h0, b_ + 2048); A2_TRRD(l1, b_ + 4096); A2_TRRD(h1, b_ + 6144); A2_TRRD(l2, b_ + 8192); A2_TRRD(h2, b_ + 10240); A2_TRRD(l3, b_ + 12288); A2_TRRD(h3, b_ + 14336); \
        asm volatile("s_waitcnt lgkmcnt(0)" ::: "memory"); A2_SBAR(); \
        o[d0] = __builtin_amdgcn_mfma_f32_32x32x16_bf16((bf16x8){l0[0], l0[1], l0[2], l0[3], h0[0], h0[1], h0[2], h0[3]}, pa0, o[d0], 0, 0, 0); \
        o[d0] = __builtin_amdgcn_mfma_f32_32x32x16_bf16((bf16x8){l1[0], l1[1], l1[2], l1[3], h1[0], h1[1], h1[2], h1[3]}, pa1, o[d0], 0, 0, 0); \
        o[d0] = __builtin_amdgcn_mfma_f32_32x32x16_bf16((bf16x8){l2[0], l2[1], l2[2], l2[3], h2[0], h2[1], h2[2], h2[3]}, pa2, o[d0], 0, 0, 0); \
        o[d0] = __builtin_amdgcn_mfma_f32_32x32x16_bf16((bf16x8){l3[0], l3[1], l3[2], l3[3], h3[0], h3[1], h3[2], h3[3]}, pa3, o[d0], 0, 0, 0); } while (0)
#define PV_REST(VB) do { asm volatile("s_waitcnt lgkmcnt(0)" ::: "memory"); A2_SBAR(); \
        o[0] = __builtin_amdgcn_mfma_f32_32x32x16_bf16((bf16x8){al0[0], al0[1], al0[2], al0[3], ah0[0], ah0[1], ah0[2], ah0[3]}, pa0, o[0], 0, 0, 0); \
        o[0] = __builtin_amdgcn_mfma_f32_32x32x16_bf16((bf16x8){al1[0], al1[1], al1[2], al1[3], ah1[0], ah1[1], ah1[2], ah1[3]}, pa1, o[0], 0, 0, 0); \
        o[0] = __builtin_amdgcn_mfma_f32_32x32x16_bf16((bf16x8){al2[0], al2[1], al2[2], al2[3], ah2[0], ah2[1], ah2[2], ah2[3]}, pa2, o[0], 0, 0, 0); \
        o[0] = __builtin_amdgcn_mfma_f32_32x32x16_bf16((bf16x8){al3[0], al3[1], al3[2], al3[3], ah3[0], ah3[1], ah3[2], ah3[3]}, pa3, o[0], 0, 0, 0); \
        A2_PV_D0(VB, 1); A2_PV_D0(VB, 2); A2_PV_D0(VB, 3); } while (0)
struct BlockRef { const bf16* Q; const bf16* K; const bf16* V; const bf16* G; bf16* Mx; int P0; int mapc; };
#define A2_VMW() asm volatile("s_waitcnt vmcnt(0)" ::: "memory")
#ifndef ATTN_DBG
#define ATTN_DBG 0
#endif
#ifndef ATTN_DBG_UNIT
#define ATTN_DBG_UNIT 0
#endif
#if ATTN_DBG
#define DBG_T() (dbg ? __builtin_amdgcn_s_memtime() : 0ull)
#define DBG_ACC(k, t0_) do { if (dbg) { const unsigned long long t1_ = __builtin_amdgcn_s_memtime(); dacc[k] += t1_ - (t0_); } } while (0)
#else
#define DBG_T() 0ull
#define DBG_ACC(k, t0_) do { } while (0)
#endif
__device__ __forceinline__ void unit_block(const BlockRef& cur, char* lds, float lam, const float* sw, float osc, int wv, unsigned long long* dbg) {
    int tid_ = wv * 64 + pg8::pg8_lane(); asm volatile("" : "+v"(tid_)); const int tid = tid_, wid = __builtin_amdgcn_readfirstlane(tid >> 6), lane = tid & 63, r32 = lane & 31, hi = lane >> 5;
    const bool grpB = wid >= 4;
#if ATTN_DBG
    unsigned long long dacc[6] = {0, 0, 0, 0, 0, 0}; const unsigned long long tu0 = DBG_T();
#endif
    const int NT = (cur.P0 + QB - 1) / KVBLK + 1;
    const int qlo = cur.P0 + wid * QBLK;
    char* V_lds = lds; char* K_lds = lds + 2 * SHM_V;
    float m_reg = 0.f, l_reg = 0; f32x16 o[4] = {}; f32x16 negm = {};
    const int sr = tid >> 4, sc = (tid & 15) * 8, vst0 = v_st(sr, sc), kr = tid >> 3, kc = (tid & 7) * 8, kws = A2_KSWZ(kr, kc * 2);
    const int vb0 = (int)(uintptr_t)V_lds + v_rd_base(lane);
    const unsigned koffB = (unsigned)(kr * PQ + kc) * 2u, voffB = (unsigned)(sr * PQ + sc) * 2u;
    const __amdgpu_buffer_rsrc_t rsK = __builtin_amdgcn_make_buffer_rsrc((void*)cur.K, (short)0, SEQ * PQ * 2, 0x00020000), rsV = __builtin_amdgcn_make_buffer_rsrc((void*)cur.V, (short)0, SEQ * PQ * 2, 0x00020000);
    bf16x8 qr[4], st_k, st_v0, st_v1;
#define A3_LDK(t) (st_k = __builtin_bit_cast(bf16x8, __builtin_amdgcn_raw_buffer_load_b128(rsK, koffB, (t) * (KVBLK * PQ * 2), 0)))
#define A3_LDV(t) do { st_v0 = __builtin_bit_cast(bf16x8, __builtin_amdgcn_raw_buffer_load_b128(rsV, voffB, (t) * (KVBLK * PQ * 2), 0)); st_v1 = __builtin_bit_cast(bf16x8, __builtin_amdgcn_raw_buffer_load_b128(rsV, voffB, (t) * (KVBLK * PQ * 2) + 32 * PQ * 2, 0)); } while (0)
#define A3_WRK(bf) (*(bf16x8*)(K_lds + (bf) * SHM_K + kws) = st_k)
#define A3_WRV(bf) do { *(bf16x8*)(V_lds + (bf) * SHM_V + vst0) = st_v0; *(bf16x8*)(V_lds + (bf) * SHM_V + vst0 + 8192) = st_v1;     } while (0)
#pragma unroll
    for (int d0 = 0; d0 < 4; ++d0) qr[d0] = load8(cur.Q + (size_t)(wid * QBLK + r32) * PQ + d0 * 16 + hi * 8);
    { A3_LDK(0); A3_LDV(0); const bf16x8 k1 = __builtin_bit_cast(bf16x8, __builtin_amdgcn_raw_buffer_load_b128(rsK, koffB, KVBLK * PQ * 2, 0)); A2_VMW(); A3_WRK(0); A3_WRV(0); *(bf16x8*)(K_lds + SHM_K + kws) = k1; }
    A3_LDK(2); A3_LDV(1);
    __syncthreads();
    f32x16 p0, p1; bf16x8 pa0, pa1, pa2, pa3;
#define A3_SOFTMAX(t) do { const unsigned long long tv_t = DBG_T(); const int kb_ = (t) * KVBLK; if (kb_ + KVBLK - 1 > qlo) mask_tile(p0, p1, qlo + r32 - 4 * hi - kb_); \
        softmax_tile(p0, p1, m_reg, negm, o, l_reg, (t) == 0, pa0, pa1, pa2, pa3); DBG_ACC(1, tv_t); } while (0)
#define A3_MFMA(t, KBN, VB) do { } while (0)
#define A3_STAGE(t, KBN, VB) do { const unsigned long long ts_ = DBG_T(); A2_VMW(); A3_WRK(VB); A3_WRV(KBN); A2_SBAR(); { const int tk_ = (t) + 3 < NT ? (t) + 3 : NT - 1, tv_ = (t) + 2 < NT ? (t) + 2 : NT - 1; A3_LDK(tk_); A3_LDV(tv_); } A2_SBAR(); DBG_ACC(2, ts_); } while (0)
#undef A3_MFMA
#define A3_MFMA(t, KBN, VB) do { const unsigned long long tm_ = DBG_T(); s16x4 al0, al1, al2, al3, ah0, ah1, ah2, ah3; PV_RD0(VB); { bf16x8 kf[8]; kload<KBN>(kf, K_lds, r32, hi); qkt(p0, p1, kf, qr, negm); } A2_SBAR(); PV_REST(VB); DBG_ACC(0, tm_); } while (0)
#define A3_BAR() do { const unsigned long long tb_ = DBG_T(); __syncthreads(); DBG_ACC(3, tb_); } while (0)
    if (!grpB) {
        { bf16x8 kf[8]; kload<0>(kf, K_lds, r32, hi); qkt(p0, p1, kf, qr, negm); } A3_BAR();
        A3_SOFTMAX(0); A3_BAR();
        for (int t = 0; t < NT; t += 2) {
            A3_STAGE(t, 1, 0); A3_MFMA(t, 1, 0); A3_BAR(); A3_SOFTMAX(t + 1); A3_BAR();
            A3_STAGE(t + 1, 0, 1); A3_MFMA(t + 1, 0, 1); A3_BAR(); if (t + 2 < NT) { A3_SOFTMAX(t + 2); } A3_BAR();
        }
    } else {
        A3_BAR();
        { bf16x8 kf[8]; kload<0>(kf, K_lds, r32, hi); qkt(p0, p1, kf, qr, negm); } A3_BAR();
        for (int t = 0; t < NT; t += 2) {
            A3_STAGE(t, 1, 0); A3_SOFTMAX(t); A3_BAR(); A3_MFMA(t, 1, 0); A3_BAR();
            A3_STAGE(t + 1, 0, 1); A3_SOFTMAX(t + 1); A3_BAR(); A3_MFMA(t + 1, 0, 1); A3_BAR();
        }
    }
    l_reg = pg8::add_xor32(l_reg);
    const float rl = __builtin_amdgcn_rcpf(l_reg);
    { bf16* stg = (bf16*)(lds + LDS_OST) + wid * (QBLK * DV); char* stb = (char*)stg; const int sbase = r32 * 256 + hi * 8, sx = r32 & 15;
      if (cur.mapc == 0) {
#pragma unroll
        for (int d0 = 0; d0 < 4; ++d0) {
#pragma unroll
          for (int g = 0; g < 4; ++g) { uint2 w; w.x = cvtpk(o[d0][4 * g] * rl, o[d0][4 * g + 1] * rl); w.y = cvtpk(o[d0][4 * g + 2] * rl, o[d0][4 * g + 3] * rl); *(uint2*)(stb + sbase + (((d0 * 4 + g) ^ sx) << 4)) = w; } }
      } else {
        u32x4 gv[8]; const bf16* Gw = cur.G + (size_t)(wid * QBLK) * PQ;
#pragma unroll
        for (int i = 0; i < 8; ++i) gv[i] = *(const u32x4*)(Gw + (size_t)(i * 4 + (lane >> 4)) * PQ + (lane & 15) * 8);
        float swv[8];
#pragma unroll
        for (int j = 0; j < 8; ++j) swv[j] = sw[(lane & 15) * 8 + j] * osc;
        const float nl = -lam * rl;
#pragma unroll
        for (int d0 = 0; d0 < 4; ++d0) {
#pragma unroll
          for (int g = 0; g < 4; ++g) { uint2* pp = (uint2*)(stb + sbase + (((d0 * 4 + g) ^ sx) << 4)); const uint2 v = *pp; uint2 w;
            w.x = cvtpk(__uint_as_float(v.x << 16) + nl * o[d0][4 * g], __uint_as_float(v.x & 0xffff0000u) + nl * o[d0][4 * g + 1]);
            w.y = cvtpk(__uint_as_float(v.y << 16) + nl * o[d0][4 * g + 2], __uint_as_float(v.y & 0xffff0000u) + nl * o[d0][4 * g + 3]); *pp = w; } }
        asm volatile("s_waitcnt lgkmcnt(0)" ::: "memory");
        bf16* Mw = cur.Mx + (size_t)(wid * QBLK) * PO;
#pragma unroll
        for (int i = 0; i < 8; ++i) { const int row = i * 4 + (lane >> 4), ch = lane & 15; const u32x4 v = *(const u32x4*)(stb + row * 256 + ((ch ^ (row & 15)) << 4));
          float d[8] = {__uint_as_float(v.x << 16), __uint_as_float(v.x & 0xffff0000u), __uint_as_float(v.y << 16), __uint_as_float(v.y & 0xffff0000u), __uint_as_float(v.z << 16), __uint_as_float(v.z & 0xffff0000u), __uint_as_float(v.w << 16), __uint_as_float(v.w & 0xffff0000u)};
          const u32x4 g = gv[i];
          const float gg[8] = {__uint_as_float(g.x << 16), __uint_as_float(g.x & 0xffff0000u), __uint_as_float(g.y << 16), __uint_as_float(g.y & 0xffff0000u), __uint_as_float(g.z << 16), __uint_as_float(g.z & 0xffff0000u), __uint_as_float(g.w << 16), __uint_as_float(g.w & 0xffff0000u)};
          float ss = 0.f;
#pragma unroll
          for (int j = 0; j < 8; ++j) ss += d[j] * d[j];
          ss += __int_as_float(__builtin_amdgcn_update_dpp(0, __float_as_int(ss), 0x128, 0xf, 0xf, false)); ss += __int_as_float(__builtin_amdgcn_update_dpp(0, __float_as_int(ss), 0x124, 0xf, 0xf, false));
          ss += __int_as_float(__builtin_amdgcn_update_dpp(0, __float_as_int(ss), 0x122, 0xf, 0xf, false)); ss += __int_as_float(__builtin_amdgcn_update_dpp(0, __float_as_int(ss), 0x121, 0xf, 0xf, false));
          const float rs = __builtin_amdgcn_rsqf(ss * (1.0f / 128.0f) + 1e-5f);
#pragma unroll
          for (int j = 0; j < 8; ++j) d[j] = d[j] * rs * swv[j] * gg[j];
          u32x4 w; w.x = cvtpk(d[0], d[1]); w.y = cvtpk(d[2], d[3]); w.z = cvtpk(d[4], d[5]); w.w = cvtpk(d[6], d[7]);
          *(u32x4*)(Mw + (size_t)row * PO + ch * 8) = w; }
      } }
#if ATTN_DBG
    if (dbg && lane == 0 && (wid == 0 || wid == 4)) { dacc[4] = __builtin_amdgcn_s_memtime() - tu0; for (int k = 0; k < 6; ++k) dbg[(wid >> 2) * 8 + k] = dacc[k]; }
#endif
    __syncthreads();
#undef A3_LDK
#undef A3_LDV
#undef A3_WRK
#undef A3_WRV
#undef A3_SOFTMAX
#undef A3_MFMA
#undef A3_STAGE
#undef A3_BAR
}
#undef A2_VMW
struct AttnTensors { const bf16* P; bf16* Mx; };
__device__ __forceinline__ BlockRef unit_ref(const AttnTensors& T, int vcu, int i) {
    const int s = vcu & 7, bh = vcu >> 3, b = bh >> 3, h = bh & 7, c = i & 1, qb = (i & 2) ? s : (NQB - 1 - s);
    BlockRef r; const size_t row0 = (size_t)b * SEQ, rowq = row0 + (size_t)qb * QB;
    r.Q = T.P + rowq * PQ + h * 128 + c * 64; r.K = T.P + row0 * PQ + 1024 + h * 128 + c * 64; r.V = T.P + row0 * PQ + 2048 + h * 128;
    r.G = T.P + rowq * PQ + 3072 + h * 128; r.Mx = T.Mx + rowq * PO + h * 128; r.P0 = qb * QB; r.mapc = c; return r;
}
__device__ __forceinline__ void attn_phase(char* lds, const AttnTensors& T, int vcu, float lam, const float* sw, float osc, int wv, unsigned long long* dbg) {
    if (vcu >= 256) return;
    for (int i = 0; i < 4; ++i) { const BlockRef cur = unit_ref(T, vcu, i); unit_block(cur, lds, lam, sw, osc, wv, (i == ATTN_DBG_UNIT && vcu == 0) ? dbg : nullptr); }
}
#undef A2_TRRD
#undef PV_RD0
#undef A2_PV_D0
#undef PV_REST
#undef A2_SBAR
#undef A2_KSWZ
}

constexpr int NWAVES = 8;
#ifndef ATTN_V2
#define ATTN_V2 1
#endif
#ifndef TAIL_COPIES
#define TAIL_COPIES 1
#endif
#ifndef FUSE_FINAL
#define FUSE_FINAL 1
#endif
#ifndef POLL_SLEEP
#define POLL_SLEEP 1
#endif
#ifndef MK_PER_PHASE
#define MK_PER_PHASE 0
#endif
constexpr int NPHASE = 8;

constexpr int BATCH = 4, SEQ = 4096, D = 2048, DEPTH = 2, NPROJ = 7680, NHEAD = 8;
constexpr int M = BATCH * SEQ;
constexpr float NORM_EPS = 1e-5f, LN_EPS = 1e-5f;
constexpr int PC_Q = 0, PC_K = 1024, PC_V = 2048, PC_GA = 3072, PC_U = 4096, PC_VS = 4608, PC_GB = 5120, PC_XC = 5632, PC_BG = 6144, PC_CG = 6656, PC_GC = 7168;

constexpr size_t MiB = 1u << 20;
constexpr size_t WS_CTL = 0, CTL_ZERO_BYTES = 1 * MiB;
constexpr size_t WS_SSQ1 = 256 * 1024;
constexpr size_t WS_DBG = 1 * MiB + 512 * 1024;
constexpr size_t WS_SSQ2 = 320 * 1024;
constexpr int CW_PANEL = 8192;
constexpr size_t WS_LNS = 384 * 1024;
constexpr size_t WS_SSQ0 = 1 * MiB;
constexpr size_t WS_TRIL = 3 * MiB;
constexpr size_t WS_WIN = 4 * MiB;
constexpr size_t WS_WOUT = 64 * MiB;
constexpr size_t WS_XB = 80 * MiB;
constexpr size_t WS_MIX = 144 * MiB;
constexpr size_t WS_PROJ = 208 * MiB;
constexpr size_t WS_END = 448 * MiB;
static_assert(WS_WIN + (size_t)DEPTH * NPROJ * D * 2 <= WS_WOUT && WS_WOUT + (size_t)DEPTH * D * D * 2 <= WS_XB && WS_XB + (size_t)M * D * 2 <= WS_MIX && WS_MIX + (size_t)M * D * 2 <= WS_PROJ && WS_PROJ + (size_t)M * NPROJ * 2 <= WS_END, "d_ws map");
constexpr int CW_BAR = 4096;

constexpr int RING_OFF = 0, RING_BYTES = 131072;
constexpr int LDSCTL_OFF = RING_BYTES, MISC_OFF = LDSCTL_OFF + 320;
constexpr int LDS_BYTES = 147456;
static_assert(MISC_OFF + 128 <= LDS_BYTES, "LDS map");

#define GAS __attribute__((address_space(1)))
#define LAS __attribute__((address_space(3)))
typedef unsigned short bf16;
typedef unsigned v4u __attribute__((ext_vector_type(4)));
typedef unsigned v2u __attribute__((ext_vector_type(2)));
typedef float f32x4 __attribute__((ext_vector_type(4)));
typedef short bf16x8 __attribute__((ext_vector_type(8)));
typedef GAS unsigned gu32;
#define RLX_AGENT __ATOMIC_RELAXED, __HIP_MEMORY_SCOPE_AGENT
#define LDS_WAIT() asm volatile("s_waitcnt lgkmcnt(0)" ::: "memory")
#define VM_WAIT() asm volatile("s_waitcnt vmcnt(0)" ::: "memory")
__device__ __forceinline__ unsigned f2bf(float f) { unsigned u = __builtin_bit_cast(unsigned, f); return (u + 0x7fffu + ((u >> 16) & 1u)) >> 16; }
__device__ __forceinline__ unsigned pk2(float lo, float hi) { return f2bf(lo) | (f2bf(hi) << 16); }
__device__ __forceinline__ float bflo(unsigned w) { return __uint_as_float(w << 16); }
__device__ __forceinline__ float bfhi(unsigned w) { return __uint_as_float(w & 0xffff0000u); }
__device__ __forceinline__ float bf1(bf16 b) { return __uint_as_float((unsigned)b << 16); }

#define XB_TMO      128
#define XB_XCNT(j)  (256  + 64 * (j))
#define XB_XSUB(j)  (1280 + 64 * (j))
#define XB_XGEN(j)  (2304 + 64 * (j))
#define XB_TOP      3328
#define XB_TOPGEN   3392
#define XCD_BAR_WORDS 3456
#define XB_SPIN_CAP (1u << 18)

__device__ __forceinline__ unsigned xb_ld(unsigned* p)              { return __hip_atomic_load(p, __ATOMIC_RELAXED, __HIP_MEMORY_SCOPE_AGENT); }
__device__ __forceinline__ unsigned xb_add(unsigned* p, unsigned v) { return __hip_atomic_fetch_add(p, v, __ATOMIC_RELAXED, __HIP_MEMORY_SCOPE_AGENT); }
__device__ __forceinline__ unsigned xb_xcc_id() { return (unsigned)__builtin_amdgcn_s_getreg((3 << 11) | 20) & 0xFu; }
#define XB_SPIN(cond, bar) do { unsigned _sp = 0; while (cond) { __builtin_amdgcn_s_sleep(POLL_SLEEP); \
    if ((++_sp & 255u) == 0u) { if (xb_ld(&(bar)[XB_TMO])) break; if (_sp > XB_SPIN_CAP) { atomicAdd(&(bar)[XB_TMO], 1u); break; } } } } while (0)

struct XcdBarrier {
    unsigned wv; unsigned* bar; unsigned x;
    volatile LAS unsigned* st;
};

__device__ __forceinline__ XcdBarrier xcd_barrier_post(unsigned* bar, volatile LAS unsigned* st) {
    XcdBarrier b; b.bar = bar; b.x = xb_xcc_id(); b.st = st;
    if (threadIdx.x == 0) (void)xb_add(&bar[XB_XCNT(b.x)], 1u);
    return b;
}
__device__ __forceinline__ void xcd_barrier_complete(unsigned* bar, unsigned x, unsigned& nloc, unsigned& nx) {
    const unsigned G = gridDim.x * gridDim.y * gridDim.z;
    unsigned sum, cnt, mine, sp = 0u;
    for (;;) {
        sum = 0u; cnt = 0u; mine = 0u;
#pragma unroll
        for (unsigned j = 0; j < 16; ++j) { const unsigned c = xb_ld(&bar[XB_XCNT(j)]); sum += c; cnt += (c > 0u) ? 1u : 0u; mine = (j == x) ? c : mine; }
        if (sum == G) break;
        __builtin_amdgcn_s_sleep(1);
        if ((++sp & 255u) == 0u) { if (xb_ld(&bar[XB_TMO])) break; if (sp > XB_SPIN_CAP) { atomicAdd(&bar[XB_TMO], 1u); break; } }
    }
    nloc = mine > 0u ? mine : 1u; nx = cnt > 0u ? cnt : 1u;
}

__device__ __forceinline__ void xcd_barrier(const XcdBarrier& b) {
    asm volatile("s_waitcnt vmcnt(0)" ::: "memory");
    __syncthreads();
    if (b.wv == 0u && pg8::pg8_lane() == 0) {
        unsigned* bar = b.bar;
        __builtin_amdgcn_s_waitcnt(0);
        unsigned nloc = b.st[0], nx = b.st[1];
        if (nloc == 0u) { xcd_barrier_complete(bar, b.x, nloc, nx); b.st[0] = nloc; b.st[1] = nx; }
        const unsigned old = xb_add(&bar[XB_XSUB(b.x)], 1u);
        const unsigned gen = old / nloc;
        if (old + 1u == (gen + 1u) * nloc) {
            __builtin_amdgcn_fence(__ATOMIC_RELEASE, "agent");
            asm volatile("s_waitcnt vmcnt(0)" ::: "memory");
            const unsigned og = xb_add(&bar[XB_TOP], 1u);
            const unsigned tg = og / nx;
            if (og + 1u == (tg + 1u) * nx) xb_add(&bar[XB_TOPGEN], 1u);
            else XB_SPIN(xb_ld(&bar[XB_TOPGEN]) == tg, bar);
            __builtin_amdgcn_fence(__ATOMIC_ACQUIRE, "agent");
            xb_add(&bar[XB_XGEN(b.x)], 1u);
            asm volatile("s_waitcnt vmcnt(0)" ::: "memory");
        } else {
            XB_SPIN(xb_ld(&bar[XB_XGEN(b.x)]) == gen, bar);
            __builtin_amdgcn_fence(__ATOMIC_ACQUIRE, "agent");
            asm volatile("s_waitcnt vmcnt(0)" ::: "memory");
        }
    }
    __syncthreads();
}

struct Frame {
    LAS unsigned char* lds;
    int tid, lane, wave;
    int vcu, G, wv;
};
__device__ __forceinline__ void frame_ids(Frame& F) {
    int t = F.wv * 64 + pg8::pg8_lane(); asm volatile("" : "+v"(t));
    F.tid = t; F.lane = t & 63; F.wave = __builtin_amdgcn_readfirstlane(t >> 6);
    int bx = blockIdx.x; asm volatile("" : "+s"(bx));
    F.G = gridDim.x; F.vcu = (F.G % 8 == 0) ? (bx % 8) * (F.G / 8) + bx / 8 : bx;
}

template <int CTRL> __device__ __forceinline__ float dpp_f(float v) { return __int_as_float(__builtin_amdgcn_update_dpp(0, __float_as_int(v), CTRL, 0xf, 0xf, false)); }
__device__ __forceinline__ float row16_sum(float v) { v += dpp_f<0x128>(v); v += dpp_f<0x124>(v); v += dpp_f<0x122>(v); v += dpp_f<0x121>(v); return v; }
__device__ __forceinline__ float wave_sum(float v) {
    v = row16_sum(v);
    const int vi = __float_as_int(v);
    const float a = __int_as_float(__builtin_amdgcn_readlane(vi, 0)), b = __int_as_float(__builtin_amdgcn_readlane(vi, 16)), c = __int_as_float(__builtin_amdgcn_readlane(vi, 32)), d = __int_as_float(__builtin_amdgcn_readlane(vi, 48));
    return (a + b) + (c + d);
}
__device__ __forceinline__ int pair_dest_row(int pair, int ch, int isB) {
    const int tile = (pair == 0) ? ((ch >> 7) < 2 ? 16 + (ch >> 7) : 18 + (ch >> 7)) : (pair == 1) ? ((ch >> 7) < 2 ? 22 + (ch >> 7) : 24 + (ch >> 7)) : ((ch >> 7) < 2 ? 24 + (ch >> 7) : 26 + (ch >> 7));
    return tile * 256 + 8 * ((ch & 127) >> 2) + (ch & 3) + 4 * isB;
}
__device__ __forceinline__ int qk_dest_row(int n) {
    if (n >= 4096) {
        if (n < 4608) return pair_dest_row(0, n - 4096, 0);
        if (n < 5120) return n;
        if (n < 5632) return pair_dest_row(0, n - 5120, 1);
        if (n < 6144) return pair_dest_row(1, n - 5632, 0);
        if (n < 6656) return pair_dest_row(2, n - 6144, 0);
        if (n < 7168) return pair_dest_row(1, n - 6656, 1);
        return pair_dest_row(2, n - 7168, 1);
    }
    if (n >= 2048) return n; const int v = n >> 6, d = n & 63; const int j = (d < 32) ? ((d >> 2) * 8 + (d & 3)) : (((d - 32) >> 2) * 8 + 4 + (d & 3)); return (v << 6) + j; }
__device__ __forceinline__ void p0_transpose_item(const float* W, int K, int N, bf16* WT, const float* kscale, bool perm, int item, int lane) {
    const int nblk = N / 64, kb = item / nblk, nb = item % nblk, k0 = 64 * kb, n = 64 * nb + lane;
    const GAS float* src = (const GAS float*)W + (size_t)k0 * N + n;
    float v[64];
#pragma unroll
    for (int i = 0; i < 64; ++i) v[i] = src[(size_t)i * N];
    if (kscale) {
#pragma unroll
        for (int i = 0; i < 64; ++i) v[i] *= kscale[k0 + i];
    }
    const int nd = perm ? qk_dest_row(n) : n;
    GAS v4u* dst = (GAS v4u*)(WT + (size_t)nd * K + k0);
#pragma unroll
    for (int j = 0; j < 8; ++j) { v4u o; o.x = pk2(v[8 * j], v[8 * j + 1]); o.y = pk2(v[8 * j + 2], v[8 * j + 3]); o.z = pk2(v[8 * j + 4], v[8 * j + 5]); o.w = pk2(v[8 * j + 6], v[8 * j + 7]); dst[j] = o; }
}
struct Args { const float* in[15]; float* out; unsigned char* ws; int ph_lo, ph_hi; };
typedef const __attribute__((address_space(4))) Args* KArgs;
__device__ __forceinline__ KArgs kargs() { KArgs p = (KArgs)__builtin_amdgcn_kernarg_segment_ptr(); asm volatile("" : "+s"(p)); return p; }
enum { I_X = 0, I_NORMW, I_WIN, I_LQ1, I_LK1, I_LQ2, I_LK2, I_SUBLN, I_LNG, I_LNB, I_WS, I_BS, I_CONVW, I_WOUT, I_FINALW };
constexpr int I_IN = (D / 64) * (NPROJ / 64), I_OUT = (D / 64) * (D / 64), I_LAYER = I_IN + I_OUT;
__device__ __forceinline__ void weight_items(Frame& F, int lo, int hi, int w, int nw) {
    KArgs ka = kargs(); unsigned char* const ws = ka->ws;
    bf16* win = (bf16*)(ws + WS_WIN); bf16* wout = (bf16*)(ws + WS_WOUT);
    const float* w_in = ka->in[I_WIN]; const float* w_out = ka->in[I_WOUT]; const float* norm_w = ka->in[I_NORMW];
    for (int it = lo + w; it < hi; it += nw) {
        int r = it; const int l = r / I_LAYER; r -= l * I_LAYER;
        if (r < I_IN) p0_transpose_item(w_in + (size_t)l * D * NPROJ, D, NPROJ, win + (size_t)l * NPROJ * D, norm_w + l * D, true, r, F.lane);
        else p0_transpose_item(w_out + (size_t)l * D * D, D, D, wout + (size_t)l * D * D, nullptr, false, r - I_IN, F.lane);
    }
}
__device__ __forceinline__ void p0_prologue(Frame& F) {
    KArgs ka = kargs(); unsigned char* const ws = ka->ws;
    const int gw = F.vcu * NWAVES + F.wave, NGW = F.G * NWAVES;
    weight_items(F, 0, TAIL_COPIES ? I_IN : DEPTH * I_LAYER, gw, NGW);
    bf16* xb = (bf16*)(ws + WS_XB); float* ssq0 = (float*)(ws + WS_SSQ0); const float* x = ka->in[I_X];
    for (int m0 = gw * 2; m0 < M; m0 += NGW * 2) {
        f32x4 v[2][8];
#pragma unroll
        for (int i = 0; i < 2; ++i)
#pragma unroll
            for (int j = 0; j < 8; ++j) v[i][j] = ((const GAS f32x4*)(x + (size_t)(m0 + i) * D))[64 * j + F.lane];
#pragma unroll
        for (int i = 0; i < 2; ++i) { float s = 0.f;
            GAS unsigned long long* o8 = (GAS unsigned long long*)(xb + (size_t)(m0 + i) * D) + F.lane;
#pragma unroll
            for (int j = 0; j < 8; ++j) { s += (v[i][j].x * v[i][j].x + v[i][j].y * v[i][j].y) + (v[i][j].z * v[i][j].z + v[i][j].w * v[i][j].w);
                o8[64 * j] = (unsigned long long)pk2(v[i][j].x, v[i][j].y) | ((unsigned long long)pk2(v[i][j].z, v[i][j].w) << 32); }
            s = wave_sum(s);
            if (F.lane == 0) ssq0[m0 + i] = s; }
    }
    const int gt = F.vcu * (NWAVES * 64) + F.tid, NGT = F.G * NWAVES * 64;
    bf16* tril = (bf16*)(ws + WS_TRIL); const float* w_s = ka->in[I_WS];
    for (int e = gt; e < DEPTH * 4 * 128 * 128; e += NGT) { const int s = e & 127, t = (e >> 7) & 127; tril[e] = (s <= t) ? (bf16)f2bf(w_s[e]) : (bf16)0; }
}

__device__ __forceinline__ void unpack8(const v4u w, float (&f)[8]) { f[0] = bflo(w.x); f[1] = bfhi(w.x); f[2] = bflo(w.y); f[3] = bfhi(w.y); f[4] = bflo(w.z); f[5] = bfhi(w.z); f[6] = bflo(w.w); f[7] = bfhi(w.w); }
__device__ __forceinline__ v4u pack8(const float (&f)[8]) { v4u w; w.x = pk2(f[0], f[1]); w.y = pk2(f[2], f[3]); w.z = pk2(f[4], f[5]); w.w = pk2(f[6], f[7]); return w; }
__device__ __forceinline__ void sgu_item(Frame& F, unsigned char* ws, const float* ln_g, const float* ln_b, const float* b_s, const float* lns, int layer, int item) {
    const int chunk = item >> 2, g = item & 3, row0 = chunk * 128, lane = F.lane, wave = F.wave;
    const bf16* proj = (const bf16*)(ws + WS_PROJ); bf16* mix = (bf16*)(ws + WS_MIX);
    LAS bf16* vnT = (LAS bf16*)(F.lds + RING_OFF);
    const int tl0 = 16 * wave, t = tl0 + (lane & 15), row = row0 + t;
    bf16 e0[16], e1[16];
#pragma unroll
    for (int tt = 0; tt < 16; ++tt) { const bf16* rp = proj + (size_t)(row0 + tl0 + tt) * NPROJ + PC_VS + g * 128; e0[tt] = rp[lane]; e1[tt] = rp[64 + lane]; }
    const float st1 = lns[2 * (size_t)row], st2 = lns[2 * (size_t)row + 1];
    const float g0 = ln_g[layer * 512 + g * 128 + lane], g1 = ln_g[layer * 512 + g * 128 + 64 + lane], b0 = ln_b[layer * 512 + g * 128 + lane], b1 = ln_b[layer * 512 + g * 128 + 64 + lane];
    const bf16* tril = (const bf16*)(ws + WS_TRIL) + (size_t)(layer * 4 + g) * 128 * 128;
    bf16x8 b[4]; v2u u2[8];
#pragma unroll
    for (int ks = 0; ks < 4; ++ks) b[ks] = *(const GAS bf16x8*)(tril + t * 128 + 32 * ks + 8 * (lane >> 4));
    const float bs = b_s[(layer * 4 + g) * 128 + t];
#pragma unroll
    for (int dt = 0; dt < 8; ++dt) { const int ch4 = g * 128 + 16 * dt + 4 * (lane >> 4); u2[dt] = *(const GAS v2u*)(proj + (size_t)row * NPROJ + PC_U + ch4); }
    const float mean_l = st1 * (1.0f / 512.0f), rstd_l = __builtin_amdgcn_rsqf(fmaxf(st2 * (1.0f / 512.0f) - mean_l * mean_l, 0.f) + LN_EPS);
#pragma unroll
    for (int tt = 0; tt < 16; ++tt) {
        const float mean = __int_as_float(__builtin_amdgcn_readlane(__float_as_int(mean_l), tt)), rstd = __int_as_float(__builtin_amdgcn_readlane(__float_as_int(rstd_l), tt));
        vnT[lane * 136 + tl0 + tt] = (bf16)f2bf((bf1(e0[tt]) - mean) * rstd * g0 + b0);
        vnT[(64 + lane) * 136 + tl0 + tt] = (bf16)f2bf((bf1(e1[tt]) - mean) * rstd * g1 + b1);
    }
    LDS_WAIT(); __syncthreads();
#pragma unroll
    for (int dt = 0; dt < 8; ++dt) {
        f32x4 acc = (f32x4){0.f, 0.f, 0.f, 0.f};
#pragma unroll
        for (int ks = 0; ks < 4; ++ks) { const bf16x8 a = *(const LAS bf16x8*)(vnT + (16 * dt + (lane & 15)) * 136 + 32 * ks + 8 * (lane >> 4)); acc = __builtin_amdgcn_mfma_f32_16x16x32_bf16(a, b[ks], acc, 0, 0, 0); }
        const int ch4 = g * 128 + 16 * dt + 4 * (lane >> 4);
        v2u o; o.x = pk2(bflo(u2[dt].x) * (acc[0] + bs), bfhi(u2[dt].x) * (acc[1] + bs)); o.y = pk2(bflo(u2[dt].y) * (acc[2] + bs), bfhi(u2[dt].y) * (acc[3] + bs));
        *(GAS v2u*)(mix + (size_t)row * D + 1024 + ch4) = o;
    }
    LDS_WAIT(); __syncthreads();
}
__device__ __forceinline__ float lam_of(KArgs ka, int layer, int lane) {
    const float a = wave_sum(ka->in[I_LQ1][layer * 64 + lane] * ka->in[I_LK1][layer * 64 + lane]), b = wave_sum(ka->in[I_LQ2][layer * 64 + lane] * ka->in[I_LK2][layer * 64 + lane]);
    const float lam_init = 0.8f - 0.6f * __expf(-0.3f * (float)layer);
    return __expf(a) - __expf(b) + lam_init;
}
__device__ __forceinline__ void mix_phase(Frame& F, int layer) {
    KArgs ka = kargs(); unsigned char* const ws = ka->ws;
    { const float* ln_g = ka->in[I_LNG]; const float* ln_b = ka->in[I_LNB]; const float* b_s = ka->in[I_BS];
      const float* lns = (const float*)(ws + WS_LNS) + (size_t)layer * M * 2;
      for (int it = F.vcu; it < 512; it += F.G) sgu_item(F, ws, ln_g, ln_b, b_s, lns, layer, it); }
    const bf16* proj = (const bf16*)(ws + WS_PROJ); bf16* mix = (bf16*)(ws + WS_MIX); const bf16* atto = (const bf16*)ka->out;
    const float* subln_w = ka->in[I_SUBLN]; const float* conv_w = ka->in[I_CONVW];
    const int lane = F.lane, gw = F.vcu * NWAVES + F.wave, NGW = F.G * NWAVES;
    const float lam_init = 0.8f - 0.6f * __expf(-0.3f * (float)layer), lam = lam_of(ka, layer, lane);
    for (int blk = gw; blk < M / 8; blk += NGW) {
        const int r0 = blk * 8;
        { float cw0[8], cw1[8], cw2[8];
#pragma unroll
          for (int j = 0; j < 8; ++j) { cw0[j] = conv_w[(layer * 3 + 0) * 512 + 8 * lane + j]; cw1[j] = conv_w[(layer * 3 + 1) * 512 + 8 * lane + j]; cw2[j] = conv_w[(layer * 3 + 2) * 512 + 8 * lane + j]; }
          v4u rx[2][6], rbg[2][4];
#pragma unroll
          for (int hb = 0; hb < 2; ++hb) { const int rb = r0 + 4 * hb; const bool halo = (rb & (SEQ - 1)) != 0;
#pragma unroll
            for (int i = 0; i < 6; ++i) { const int row = (halo || i >= 2) ? rb - 2 + i : rb; const bf16* rp = proj + (size_t)row * NPROJ + 8 * lane; rx[hb][i] = *(const GAS v4u*)(rp + PC_XC); }
#pragma unroll
            for (int i = 0; i < 4; ++i) { const bf16* rp = proj + (size_t)(rb + i) * NPROJ + 8 * lane; rbg[hb][i] = *(const GAS v4u*)(rp + PC_BG); } }
#pragma unroll
          for (int hb = 0; hb < 2; ++hb) { const int rb = r0 + 4 * hb; const bool halo = (rb & (SEQ - 1)) != 0;
            float z[6][8];
#pragma unroll
            for (int i = 0; i < 6; ++i) { float a[8]; unpack8(rx[hb][i], a);
#pragma unroll
                for (int j = 0; j < 8; ++j) z[i][j] = (halo || i >= 2) ? a[j] : 0.f; }
#pragma unroll
            for (int i = 0; i < 4; ++i) { float bg[8], y[8]; unpack8(rbg[hb][i], bg);
#pragma unroll
                for (int j = 0; j < 8; ++j) y[j] = bg[j] * (cw0[j] * z[i][j] + cw1[j] * z[i + 1][j] + cw2[j] * z[i + 2][j]);
                *(GAS v4u*)(mix + (size_t)(rb + i) * D + 1536 + 8 * lane) = pack8(y); }
          } }
    }
}
__device__ __forceinline__ void final_norm(Frame& F) {
    KArgs ka = kargs(); float* const out = ka->out; const float* final_w = ka->in[I_FINALW]; const bf16* xb = (const bf16*)(ka->ws + WS_XB);
    const int gw = F.vcu * NWAVES + F.wave, NGW = F.G * NWAVES;
    for (int m0 = gw * 4; m0 < M; m0 += NGW * 4) {
        v4u raw[4][4];
#pragma unroll
        for (int i = 0; i < 4; ++i)
#pragma unroll
            for (int j = 0; j < 4; ++j) raw[i][j] = ((const GAS v4u*)(xb + (size_t)(m0 + i) * D))[64 * j + F.lane];
#pragma unroll
        for (int i = 0; i < 4; ++i) { float v[4][8]; float s = 0.f;
#pragma unroll
            for (int j = 0; j < 4; ++j) { unpack8(raw[i][j], v[j]);
#pragma unroll
                for (int e = 0; e < 8; ++e) s += v[j][e] * v[j][e]; }
            const float rs = __builtin_amdgcn_rsqf(wave_sum(s) * (1.0f / 2048.0f) + NORM_EPS);
            GAS f32x4* orow = (GAS f32x4*)(out + (size_t)(m0 + i) * D);
#if ATTN_DBG || GEMM_DBG
            const float dbgv = (m0 + i == 0 && F.lane == 0) ? (float)((const unsigned long long*)(ka->ws + WS_DBG))[ATTN_DBG_SEL] * ATTN_DBG_SCALE : 0.f;
#endif
#pragma unroll
            for (int j = 0; j < 4; ++j) { const f32x4 w0 = ((const GAS f32x4*)final_w)[128 * j + 2 * F.lane], w1 = ((const GAS f32x4*)final_w)[128 * j + 2 * F.lane + 1];
#if ATTN_DBG || GEMM_DBG
                if (j == 0 && dbgv != 0.f) v[0][0] = dbgv / (rs * w0.x);
#endif
                orow[128 * j + 2 * F.lane] = (f32x4){v[j][0] * rs * w0.x, v[j][1] * rs * w0.y, v[j][2] * rs * w0.z, v[j][3] * rs * w0.w};
                orow[128 * j + 2 * F.lane + 1] = (f32x4){v[j][4] * rs * w1.x, v[j][5] * rs * w1.y, v[j][6] * rs * w1.z, v[j][7] * rs * w1.w}; }
        }
    }
}

__global__ void __launch_bounds__(NWAVES * 64, 2) hybrid_fwd(Args args) {
    extern __shared__ __attribute__((aligned(16))) unsigned char lds[];
    Frame F;
    F.lds = (LAS unsigned char*)lds;
    F.wv = __builtin_amdgcn_readfirstlane((int)threadIdx.x >> 6);
    volatile LAS unsigned* MISC = (volatile LAS unsigned*)(F.lds + MISC_OFF);
    for (int u = threadIdx.x; u < (LDS_BYTES - LDSCTL_OFF) / 4; u += NWAVES * 64) ((LAS unsigned*)(F.lds + LDSCTL_OFF))[u] = 0u;
    __syncthreads();
    XcdBarrier bar; bar.bar = (unsigned*)(args.ws + WS_CTL) + CW_BAR; bar.x = 0; bar.st = nullptr;
    if (!MK_PER_PHASE) bar = xcd_barrier_post((unsigned*)(args.ws + WS_CTL) + CW_BAR, MISC + 8);
    bar.wv = (unsigned)F.wv;
    const int lo = args.ph_lo, hi = args.ph_hi;
#ifndef PH_MASK
#define PH_MASK 0x3f
#endif
#define IN(k) (lo <= (k) && (k) < hi)
#define EN(b) ((PH_MASK >> (b)) & 1)
#ifndef REP_MASK
#define REP_MASK 0
#endif
#define NREP(b) (((REP_MASK >> (b)) & 1) + 1)
#define SEAM(k) do { if (IN(k) && IN((k) + 1)) xcd_barrier(bar); } while (0)

    if (EN(0) && IN(0)) { for (int rep = 0; rep < NREP(0); ++rep) { if (rep) xcd_barrier(bar); frame_ids(F); p0_prologue(F); } } SEAM(0);
    for (int layer = 0; layer < DEPTH; ++layer) {
        const int pb = 1 + 3 * layer;
        if (EN(1) && IN(pb)) for (int rep = 0; rep < NREP(1); ++rep) {
            if (rep) xcd_barrier(bar);
            unsigned char* const ws = kargs()->ws;
            pg8::Gemm g{(const pg8::bf16_t*)(ws + WS_XB), (const pg8::bf16_t*)(ws + WS_WIN) + (size_t)layer * NPROJ * D, M, NPROJ, D, (GEMM_DBG == 1 && layer == 0) ? (unsigned long long*)(ws + WS_DBG) : nullptr};
            pg8::StaticOrder S; S.init(M, NPROJ, (int)gridDim.x, (int)blockIdx.x); S.wv = F.wv;
            pg8::EpiProj E{(pg8::bf16_t*)(ws + WS_PROJ), (const float*)(ws + (layer == 0 ? WS_SSQ0 : WS_SSQ1)), (float*)(ws + WS_LNS) + (size_t)layer * M * 2, (LAS float*)(F.lds + LDSCTL_OFF + 1024)};
            pg8::gemm_phase<pg8::EpiProj, pg8::StaticOrder, PG8_ALIGN, PG8_SP2>(F.lds + RING_OFF, g, S, E);
            if (TAIL_COPIES && rep == 0) {
                const int G_ = (int)gridDim.x, nwg = (M / 256) * (NPROJ / 256), full = nwg % G_;
                if (full != 0 && (int)blockIdx.x >= full) { frame_ids(F); const int w = ((int)blockIdx.x - full) * NWAVES + F.wave, nw = (G_ - full) * NWAVES;
                    if (layer == 0) weight_items(F, I_IN, I_LAYER + I_IN, w, nw); else weight_items(F, I_LAYER + I_IN, 2 * I_LAYER, w, nw); }
                else if (full == 0 && layer == 0) { frame_ids(F); weight_items(F, I_IN, 2 * I_LAYER, F.vcu * NWAVES + F.wave, F.G * NWAVES); }
            }
        }
        SEAM(pb);
        if (IN(pb + 1)) for (int rep = 0; rep < NREP(2) + NREP(3) - 1; ++rep) {
            if (rep) xcd_barrier(bar);
            frame_ids(F); const bool mix_first = ((F.vcu >> 3) & 1) == 0;
            for (int st = 0; st < 2; ++st) {
                if ((st == 0) == mix_first) { if (EN(3) && (rep == 0 || NREP(3) == 2)) { frame_ids(F); mix_phase(F, layer); } }
                else if (EN(2) && (rep == 0 || NREP(2) == 2)) {
                    KArgs ka = kargs(); unsigned char* const ws = ka->ws; frame_ids(F);
                    const float lam_init = 0.8f - 0.6f * __expf(-0.3f * (float)layer), lam = lam_of(ka, layer, F.lane);
                    const attn2::AttnTensors AT{(const attn2::bf16*)(ws + WS_PROJ), (attn2::bf16*)(ws + WS_MIX)};
                    attn2::attn_phase((char*)lds + RING_OFF, AT, F.vcu, lam, ka->in[I_SUBLN] + layer * 128, 1.0f - lam_init, F.wv, (ATTN_DBG && layer == 0) ? (unsigned long long*)(ws + WS_DBG) : nullptr);
                }
            }
        }
        SEAM(pb + 1);
        if (EN(4) && IN(pb + 2)) for (int rep = 0; rep < (layer == 0 ? NREP(4) : 1); ++rep) {
            if (rep) xcd_barrier(bar);
            KArgs ka = kargs(); unsigned char* const ws = ka->ws; const float* xin = ka->in[I_X];
            pg8::Gemm g{(const pg8::bf16_t*)(ws + WS_MIX), (const pg8::bf16_t*)(ws + WS_WOUT) + (size_t)layer * D * D, M, D, D, (GEMM_DBG == 2 && layer == 0) ? (unsigned long long*)(ws + WS_DBG) : nullptr};
            if (FUSE_FINAL && layer == DEPTH - 1) {
                frame_ids(F); pg8::PanelOrder S{F.vcu, F.G, F.wv};
                pg8::EpiFinal E{(const pg8::bf16_t*)(ws + WS_XB), ka->out, ka->in[I_FINALW], (float*)(ws + WS_SSQ2), (unsigned*)(ws + WS_CTL) + CW_PANEL};
                pg8::gemm_phase<pg8::EpiFinal, pg8::PanelOrder, PG8_ALIGN, PG8_SP2>(F.lds + RING_OFF, g, S, E);
            } else {
            pg8::StaticOrder S; S.init(M, D, (int)gridDim.x, (int)blockIdx.x); S.wv = F.wv;
            pg8::EpiResid E{nullptr, (const pg8::bf16_t*)(ws + WS_XB), (pg8::bf16_t*)(ws + WS_XB), (layer == 0 && rep == 0) ? (float*)(ws + WS_SSQ1) : nullptr};
            pg8::gemm_phase<pg8::EpiResid, pg8::StaticOrder, PG8_ALIGN, PG8_SP2>(F.lds + RING_OFF, g, S, E);
            }
        }
        if (!(FUSE_FINAL && layer == DEPTH - 1)) SEAM(pb + 2);
    }
    if (!FUSE_FINAL && EN(5) && IN(7)) { frame_ids(F); final_norm(F); }
#undef IN
#undef SEAM
}

extern "C" void kernel_launch(void* const* d_in, const int* in_sizes, int n_in, void* d_out, int out_size, void* d_ws, size_t ws_size, hipStream_t stream) {
    static int grid = 0;
    if (grid == 0) {
        if (n_in != 15 || in_sizes[0] != M * D || out_size != M * D || ws_size < WS_END) { fprintf(stderr, "kernel_launch: shape/workspace mismatch (n_in %d, in0 %d, out %d, ws %zu); nothing launched\n", n_in, n_in > 0 ? in_sizes[0] : -1, out_size, ws_size); grid = -1; return; }
        int dev = 0, cus = 0, per_cu = 0;
        if (hipGetDevice(&dev) != hipSuccess || hipDeviceGetAttribute(&cus, hipDeviceAttributeMultiprocessorCount, dev) != hipSuccess) { grid = -1; return; }
        if (hipFuncSetAttribute((const void*)hybrid_fwd, hipFuncAttributeMaxDynamicSharedMemorySize, LDS_BYTES) != hipSuccess) { fprintf(stderr, "kernel_launch: hipFuncSetAttribute failed\n"); grid = -1; return; }
        if (hipOccupancyMaxActiveBlocksPerMultiprocessor(&per_cu, (const void*)hybrid_fwd, NWAVES * 64, LDS_BYTES) != hipSuccess || per_cu < 1)
            fprintf(stderr, "kernel_launch: note: occupancy query reports %d workgroups per CU\n", per_cu);
        (void)hipGetLastError();
        grid = cus;
    }
    if (grid < 0) return;
    if (hipMemsetAsync((char*)d_ws + WS_CTL, 0, CTL_ZERO_BYTES, stream) != hipSuccess) { fprintf(stderr, "kernel_launch: hipMemsetAsync failed\n"); return; }
    Args a{};
    for (int i = 0; i < 15; ++i) a.in[i] = (const float*)d_in[i];
    a.out = (float*)d_out; a.ws = (unsigned char*)d_ws;
#if MK_PER_PHASE
    for (int p = 0; p < NPHASE; ++p) { a.ph_lo = p; a.ph_hi = p + 1; hipLaunchKernelGGL(hybrid_fwd, dim3(grid), dim3(NWAVES * 64), LDS_BYTES, stream, a); }
#else
    a.ph_lo = 0; a.ph_hi = NPHASE;
    hipLaunchKernelGGL(hybrid_fwd, dim3(grid), dim3(NWAVES * 64), LDS_BYTES, stream, a);
#endif
    const hipError_t le = hipPeekAtLastError();
    if (le != hipSuccess) fprintf(stderr, "kernel_launch: launch failed: %s\n", hipGetErrorName(le));
}
```

```cpp
#include <hip/hip_runtime.h>
#include <cstdio>
#include <cstdint>
namespace pg8 {
#define PG8_LAS __attribute__((address_space(3)))
typedef unsigned short bf16_t;
typedef short bf16x8 __attribute__((ext_vector_type(8)));
typedef float f32x4 __attribute__((ext_vector_type(4)));
typedef unsigned u32x4 __attribute__((ext_vector_type(4)));
constexpr int BM = 256, BK = 64, HALF = 128, HTB = HALF * BK * 2  , STAGE_BYTES = 8 * HTB, NXCD = 8, WGM = 8;

__host__ __device__ __forceinline__ int lds_byte(int r, int c) { const int st = (r >> 4) * 2 + (c >> 5), rr = r & 15, cc = c & 31, ob = rr * 64 + cc * 2; return st * 1024 + (ob ^ (((ob >> 9) & 1) << 5)); }
__host__ __device__ __forceinline__ void stage_rc(int b, int& R, int& C) { const int st = b / 1024, sb = b % 1024, swz = sb ^ (((sb >> 9) & 1) << 5); R = (st >> 1) * 16 + swz / 64; C = (st & 1) * 32 + (swz % 64) / 2; }
__host__ __device__ __forceinline__ int perm32(int rho) { const int n = rho >> 4, i = rho & 15; return 8 * (i >> 2) + 4 * n + (i & 3); }

struct Unit { int pm, pn, seq; };
#ifndef GEMM_DBG
#define GEMM_DBG 0
#endif
struct Gemm { const bf16_t* A; const bf16_t* Bt; int M, N, K; unsigned long long* dbg; };

struct StaticOrder {
    int nM, nN, nwg, G, c, wv;
    __host__ __device__ void init(int M, int N, int G_, int c_) { nM = M / BM; nN = N / BM; nwg = nM * nN; G = G_; c = c_; }
    __host__ __device__ bool next(int i, Unit& u) const {
        const long L = (long)i * G + c; if (L >= nwg) return false;
        int wgid = (int)L; { const int q = nwg / NXCD, r = nwg % NXCD, xcd = wgid % NXCD, off = wgid / NXCD; wgid = (xcd < r ? xcd * (q + 1) : r * (q + 1) + (xcd - r) * q) + off; }
        const int nig = WGM * nN, gid = wgid / nig, fm = gid * WGM, gsz = (nM - fm) < WGM ? (nM - fm) : WGM;
        u.pm = fm + ((wgid % nig) % gsz); u.pn = (wgid % nig) / gsz; return true;
    }
    __device__ __forceinline__ void a_ready(const Unit&) const {}
    __device__ __forceinline__ void done(const Unit&) const {}
};

__device__ __forceinline__ int pg8_lane() { int l; asm volatile("v_mbcnt_lo_u32_b32 %0, -1, 0\n\tv_mbcnt_hi_u32_b32 %0, -1, %0" : "=v"(l)); return l; }
__device__ __forceinline__ float add_xor16(float v) { return v + __int_as_float(__builtin_amdgcn_ds_swizzle(__float_as_int(v), 0x401F)); }
__device__ __forceinline__ float add_xor32(float v) { auto rr = __builtin_amdgcn_permlane32_swap(__float_as_uint(v), __float_as_uint(v), false, false); return __uint_as_float(rr[0]) + __uint_as_float(rr[1]); }
__device__ __forceinline__ unsigned cvt_pk_bf16(float lo, float hi) { unsigned r; asm volatile("v_cvt_pk_bf16_f32 %0, %1, %2" : "=v"(r) : "v"(lo), "v"(hi)); return r; }
typedef float f32x2 __attribute__((ext_vector_type(2)));
constexpr float QK_C2 = 0.125f * 1.4426950408889634f;
constexpr int PROJ_LD = 7680, DMODEL = 2048;
__device__ __forceinline__ float silu_f(float v) { return v * __builtin_amdgcn_rcpf(1.0f + __builtin_amdgcn_exp2f(-1.4426950408889634f * v)); }
struct EpiProj {
    static constexpr bool PERM = true, AFTER_DRAIN = false, PREFETCH = true;
    bf16_t* O; const float* ssq; float* lns; PG8_LAS float* side;
    __device__ __forceinline__ void prefetch(const Unit& u, int wid, int lane) const {
        if (wid < 4) __builtin_amdgcn_global_load_lds((const unsigned*)(ssq + u.pm * BM + wid * 64 + lane), (PG8_LAS unsigned*)(side + (u.seq & 1) * 256 + wid * 64), 4, 0, 0);
    }
    __device__ __forceinline__ void operator()(const f32x4 (&acc)[2][2][4][2], const Unit& u, int wr, int wc, int fr, int fq) const {
        const int row0 = u.pm * BM + wr * 64 + fr, col0 = u.pn * BM + wc * 32 + 8 * fq, pn = u.pn;
        const int mode = (pn < 8) ? 1 : ((pn >= 12 && pn < 16) ? 2 : ((pn >= 16 && pn != 18 && pn != 19) ? 3 : 0));
        const bool pair_silu = !(pn == 22 || pn == 23 || pn == 26 || pn == 27);
        const int pair_col = (pn <= 21 ? 4096 + ((pn == 16 || pn == 17) ? (pn - 16) : (pn - 18)) * 128
                              : (pn == 22 || pn == 23 || pn == 26 || pn == 27) ? 5632 + ((pn < 24) ? (pn - 22) : (pn - 24)) * 128
                              : 6144 + ((pn < 26) ? (pn - 24) : (pn - 26)) * 128) + 32 * wc + 8 * fq;
        const float qs = (pn < 4) ? QK_C2 : 1.0f;
        const PG8_LAS float* sq = side + (u.seq & 1) * 256 + wr * 64 + fr;
        float ci[4], c128[4];
#pragma unroll
        for (int e = 0; e < 4; ++e) { const int i = 4 * (4 * (wc & 1) + fq) + e; ci[e] = __builtin_amdgcn_exp2f(-0.41524101186092029f * (float)i) * 0.15915494309189535f; c128[e] = __builtin_amdgcn_fractf(128.0f * ci[e]); }
#pragma unroll
        for (int ai = 0; ai < 2; ++ai)
#pragma unroll
            for (int m = 0; m < 4; ++m) {
                const int row = row0 + ai * HALF + m * 16;
                const float rs = __builtin_amdgcn_rsqf(sq[ai * HALF + m * 16] * (1.0f / 2048.0f) + 1e-5f);
                bf16_t* rowp = O + (size_t)row * PROJ_LD + col0;
                if (mode == 1) {
                    const int p = row & 4095; const float ph = (float)(p >> 7), pl = (float)(p & 127);
                    f32x4 c4, s4;
#pragma unroll
                    for (int e = 0; e < 4; ++e) { const float rev = __builtin_amdgcn_fractf(ph * c128[e] + pl * ci[e]); c4[e] = __builtin_amdgcn_cosf(rev); s4[e] = __builtin_amdgcn_sinf(rev); }
                    const float sc = rs * qs;
#pragma unroll
                    for (int bj = 0; bj < 2; ++bj) { const f32x4 v0 = acc[ai][bj][m][0] * sc, v1 = acc[ai][bj][m][1] * sc;
                        const f32x4 o0 = v0 * c4 - v1 * s4, o1 = v1 * c4 + v0 * s4;
                        u32x4 w; w.x = cvt_pk_bf16(o0[0], o0[1]); w.y = cvt_pk_bf16(o0[2], o0[3]); w.z = cvt_pk_bf16(o1[0], o1[1]); w.w = cvt_pk_bf16(o1[2], o1[3]);
                        *(u32x4*)(rowp + bj * HALF) = w; }
                } else if (mode == 3) {
                    u32x4 w;
#pragma unroll
                    for (int n = 0; n < 2; ++n) { const f32x4 va = acc[ai][0][m][n] * rs; f32x4 vb = acc[ai][1][m][n] * rs;
                        if (pair_silu) {
#pragma unroll
                            for (int j = 0; j < 4; ++j) vb[j] = silu_f(vb[j]); }
                        const f32x4 pr = va * vb; if (n == 0) { w.x = cvt_pk_bf16(pr[0], pr[1]); w.y = cvt_pk_bf16(pr[2], pr[3]); } else { w.z = cvt_pk_bf16(pr[0], pr[1]); w.w = cvt_pk_bf16(pr[2], pr[3]); } }
                    *(u32x4*)(O + (size_t)row * PROJ_LD + pair_col) = w;
                } else if (mode == 2) {
#pragma unroll
                    for (int bj = 0; bj < 2; ++bj) { f32x4 v0 = acc[ai][bj][m][0] * rs, v1 = acc[ai][bj][m][1] * rs;
#pragma unroll
                        for (int j = 0; j < 4; ++j) { v0[j] = silu_f(v0[j]); v1[j] = silu_f(v1[j]); }
                        u32x4 w; w.x = cvt_pk_bf16(v0[0], v0[1]); w.y = cvt_pk_bf16(v0[2], v0[3]); w.z = cvt_pk_bf16(v1[0], v1[1]); w.w = cvt_pk_bf16(v1[2], v1[3]);
                        *(u32x4*)(rowp + bj * HALF) = w; }
                } else {
                    float s1 = 0.f, s2 = 0.f;
#pragma unroll
                    for (int bj = 0; bj < 2; ++bj) { const f32x4 v0 = acc[ai][bj][m][0] * rs, v1 = acc[ai][bj][m][1] * rs;
                        u32x4 w; w.x = cvt_pk_bf16(v0[0], v0[1]); w.y = cvt_pk_bf16(v0[2], v0[3]); w.z = cvt_pk_bf16(v1[0], v1[1]); w.w = cvt_pk_bf16(v1[2], v1[3]);
                        *(u32x4*)(rowp + bj * HALF) = w;
                        s1 += ((v0[0] + v0[1]) + (v0[2] + v0[3])) + ((v1[0] + v1[1]) + (v1[2] + v1[3]));
                        s2 += ((v0[0] * v0[0] + v0[1] * v0[1]) + (v0[2] * v0[2] + v0[3] * v0[3])) + ((v1[0] * v1[0] + v1[1] * v1[1]) + (v1[2] * v1[2] + v1[3] * v1[3])); }
                    if (pn == 18 || pn == 19) {
                        s1 = add_xor32(add_xor16(s1)); s2 = add_xor32(add_xor16(s2));
                        if (fq == 0) { atomicAdd(lns + 2 * row, s1); atomicAdd(lns + 2 * row + 1, s2); } }
                }
            }
    }
};
struct EpiResid {
    static constexpr bool PERM = true, AFTER_DRAIN = false, PREFETCH = false;
    const float* base32; const bf16_t* base16; bf16_t* xb; float* ssq;
    __device__ __forceinline__ void operator()(const f32x4 (&acc)[2][2][4][2], const Unit& u, int wr, int wc, int fr, int fq) const {
        const int row0 = u.pm * BM + wr * 64 + fr, col0 = u.pn * BM + wc * 32 + 8 * fq;
#pragma unroll
        for (int ai = 0; ai < 2; ++ai) {
            f32x4 b[4][2][2];
            if (base32) {
#pragma unroll
                for (int m = 0; m < 4; ++m) { const size_t off = (size_t)(row0 + ai * HALF + m * 16) * DMODEL + col0;
#pragma unroll
                    for (int bj = 0; bj < 2; ++bj) { b[m][bj][0] = *(const f32x4*)(base32 + off + bj * HALF); b[m][bj][1] = *(const f32x4*)(base32 + off + bj * HALF + 4); } }
            } else {
                u32x4 bw[4][2];
#pragma unroll
                for (int m = 0; m < 4; ++m) { const size_t off = (size_t)(row0 + ai * HALF + m * 16) * DMODEL + col0;
#pragma unroll
                    for (int bj = 0; bj < 2; ++bj) bw[m][bj] = *(const u32x4*)(base16 + off + bj * HALF); }
#pragma unroll
                for (int m = 0; m < 4; ++m)
#pragma unroll
                    for (int bj = 0; bj < 2; ++bj) { const u32x4 w = bw[m][bj];
                        b[m][bj][0] = (f32x4){__uint_as_float(w.x << 16), __uint_as_float(w.x & 0xffff0000u), __uint_as_float(w.y << 16), __uint_as_float(w.y & 0xffff0000u)};
                        b[m][bj][1] = (f32x4){__uint_as_float(w.z << 16), __uint_as_float(w.z & 0xffff0000u), __uint_as_float(w.w << 16), __uint_as_float(w.w & 0xffff0000u)}; }
            }
#pragma unroll
            for (int m = 0; m < 4; ++m) {
                const int row = row0 + ai * HALF + m * 16; const size_t off = (size_t)row * DMODEL + col0;
                float part = 0.f;
#pragma unroll
                for (int bj = 0; bj < 2; ++bj) { const f32x4 x0 = b[m][bj][0] + acc[ai][bj][m][0], x1 = b[m][bj][1] + acc[ai][bj][m][1];
                    u32x4 w; w.x = cvt_pk_bf16(x0[0], x0[1]); w.y = cvt_pk_bf16(x0[2], x0[3]); w.z = cvt_pk_bf16(x1[0], x1[1]); w.w = cvt_pk_bf16(x1[2], x1[3]); *(u32x4*)(xb + off + bj * HALF) = w;
                    part += (x0[0] * x0[0] + x0[1] * x0[1]) + (x0[2] * x0[2] + x0[3] * x0[3]) + (x1[0] * x1[0] + x1[1] * x1[1]) + (x1[2] * x1[2] + x1[3] * x1[3]); }
                if (ssq) { part = add_xor32(add_xor16(part)); if (fq == 0) atomicAdd(ssq + row, part); }
            }
        }
    }
};

struct PanelOrder {
    int vcu, G, wv;
    __device__ __forceinline__ bool next(int i, Unit& u) const { if (i >= 2 || G != 256) return false; u.pm = 32 * i + (vcu >> 3); u.pn = vcu & 7; u.seq = 0; return true; }
    __device__ __forceinline__ void a_ready(const Unit&) const {}
    __device__ __forceinline__ void done(const Unit&) const {}
};
struct EpiFinal {
    static constexpr bool PERM = true, AFTER_DRAIN = false, PREFETCH = false;
    const bf16_t* base16; float* out; const float* fw; float* ssq; unsigned* cnt;
    __device__ __forceinline__ void operator()(const f32x4 (&acc_)[2][2][4][2], const Unit& u, int wr, int wc, int fr, int fq) const {
        f32x4 (&acc)[2][2][4][2] = const_cast<f32x4 (&)[2][2][4][2]>(acc_);
        const int row0 = u.pm * BM + wr * 64 + fr, col0 = u.pn * BM + wc * 32 + 8 * fq;
        f32x4 wv[2][2];
#pragma unroll
        for (int bj = 0; bj < 2; ++bj) { wv[bj][0] = *(const f32x4*)(fw + col0 + bj * HALF); wv[bj][1] = *(const f32x4*)(fw + col0 + bj * HALF + 4); }
#pragma unroll
        for (int ai = 0; ai < 2; ++ai) {
            u32x4 bw[4][2];
#pragma unroll
            for (int m = 0; m < 4; ++m) { const size_t off = (size_t)(row0 + ai * HALF + m * 16) * DMODEL + col0;
#pragma unroll
                for (int bj = 0; bj < 2; ++bj) bw[m][bj] = *(const u32x4*)(base16 + off + bj * HALF); }
#pragma unroll
            for (int m = 0; m < 4; ++m) { float part = 0.f;
#pragma unroll
                for (int bj = 0; bj < 2; ++bj) { const u32x4 w = bw[m][bj];
                    const f32x4 b0 = (f32x4){__uint_as_float(w.x << 16), __uint_as_float(w.x & 0xffff0000u), __uint_as_float(w.y << 16), __uint_as_float(w.y & 0xffff0000u)};
                    const f32x4 b1 = (f32x4){__uint_as_float(w.z << 16), __uint_as_float(w.z & 0xffff0000u), __uint_as_float(w.w << 16), __uint_as_float(w.w & 0xffff0000u)};
                    const f32x4 x0 = b0 + acc[ai][bj][m][0], x1 = b1 + acc[ai][bj][m][1]; acc[ai][bj][m][0] = x0; acc[ai][bj][m][1] = x1;
                    part += (x0[0] * x0[0] + x0[1] * x0[1]) + (x0[2] * x0[2] + x0[3] * x0[3]) + (x1[0] * x1[0] + x1[1] * x1[1]) + (x1[2] * x1[2] + x1[3] * x1[3]); }
                part = add_xor32(add_xor16(part));
                if (fq == 0) atomicAdd(ssq + row0 + ai * HALF + m * 16, part); }
        }
        asm volatile("s_waitcnt vmcnt(0)" ::: "memory");
        unsigned* c = cnt + 64 * u.pm;
        if (pg8_lane() == 0) __hip_atomic_fetch_add(c, 1u, __ATOMIC_RELAXED, __HIP_MEMORY_SCOPE_AGENT);
        { unsigned spins = 0;
          while ((unsigned)__builtin_amdgcn_readfirstlane(__hip_atomic_load(c, __ATOMIC_RELAXED, __HIP_MEMORY_SCOPE_AGENT)) < 64u) { __builtin_amdgcn_s_sleep(2); if (++spins > (1u << 22)) break; } }
        asm volatile("" ::: "memory");
        float ssv[2][4];
#pragma unroll
        for (int ai = 0; ai < 2; ++ai)
#pragma unroll
            for (int m = 0; m < 4; ++m) ssv[ai][m] = __hip_atomic_load(ssq + row0 + ai * HALF + m * 16, __ATOMIC_RELAXED, __HIP_MEMORY_SCOPE_AGENT);
#pragma unroll
        for (int ai = 0; ai < 2; ++ai)
#pragma unroll
            for (int m = 0; m < 4; ++m) { const int row = row0 + ai * HALF + m * 16;
                const float ss = ssv[ai][m];
                const float rs = __builtin_amdgcn_rsqf(ss * (1.0f / 2048.0f) + 1e-5f); float* rowp = out + (size_t)row * DMODEL + col0;
#pragma unroll
                for (int bj = 0; bj < 2; ++bj) { *(f32x4*)(rowp + bj * HALF) = acc[ai][bj][m][0] * rs * wv[bj][0]; *(f32x4*)(rowp + bj * HALF + 4) = acc[ai][bj][m][1] * rs * wv[bj][1]; } }
    }
};


template <class Epi, class Sched, bool ALIGN_EPI = false, bool SP2 = false>
__device__ __forceinline__ void gemm_phase(PG8_LAS unsigned char* lds, const Gemm g, const Sched& S, const Epi& E) {
    int tid_ = S.wv * 64 + pg8_lane(); asm volatile("" : "+v"(tid_));
    const int tid = tid_, wid = __builtin_amdgcn_readfirstlane(tid >> 6), lane = tid & 63, wr = wid >> 2, wc = wid & 3, fr = lane & 15, fq = lane >> 4;
    const int K = g.K, nt = K / BK;
    unsigned voffA[2], voffB[2];
#pragma unroll
    for (int i = 0; i < 2; ++i) { int R, C; stage_rc(tid * 16 + i * 8192, R, C); const int Rb = Epi::PERM ? ((R & ~31) + perm32(R & 31)) : R;
        voffA[i] = (unsigned)(R * K + C) * 2u; voffB[i] = (unsigned)(Rb * K + C) * 2u; }
    const size_t kstep = (size_t)(BK * 2);
    const size_t hstep = (size_t)HALF * K * 2;
    const size_t tstep = 2 * hstep;
    const unsigned ldsw = (unsigned)wid * 1024u;
    const int aoff = lds_byte(wr * 64 + fr, fq * 8), boff = lds_byte(wc * 32 + fr, fq * 8);
#define PG8_SA(b, h) (((b) * 2 + (h)) * HTB)
#define PG8_SB(b, h) ((4 + (b) * 2 + (h)) * HTB)
#define PG8_STAGE(bufoff, gbase, voff) do { _Pragma("unroll") for (int _i = 0; _i < 2; ++_i) \
        __builtin_amdgcn_global_load_lds((const unsigned*)((const char*)(gbase) + (voff)[_i]), (PG8_LAS unsigned*)(lds + (bufoff) + ldsw + _i * 8192), 16, 0, 0); } while (0)
#define PG8_LDA(dst, b, h) do { _Pragma("unroll") for (int m = 0; m < 4; ++m) _Pragma("unroll") for (int k = 0; k < 2; ++k) dst[m][k] = *(const PG8_LAS bf16x8*)(lds + PG8_SA(b, h) + aoff + m * 2048 + k * 1024); } while (0)
#define PG8_LDB(dst, b, h) do { _Pragma("unroll") for (int n = 0; n < 2; ++n) _Pragma("unroll") for (int k = 0; k < 2; ++k) dst[n][k] = *(const PG8_LAS bf16x8*)(lds + PG8_SB(b, h) + boff + n * 2048 + k * 1024); } while (0)
#define PG8_MMA(ai, bj, At, Bt) do { __builtin_amdgcn_s_setprio(1); _Pragma("unroll") for (int m = 0; m < 4; ++m) _Pragma("unroll") for (int n = 0; n < 2; ++n) _Pragma("unroll") for (int k = 0; k < 2; ++k) \
        acc[ai][bj][m][n] = __builtin_amdgcn_mfma_f32_16x16x32_bf16(Bt[n][k], At[m][k], acc[ai][bj][m][n], 0, 0, 0); __builtin_amdgcn_s_setprio(0); } while (0)
#define PG8_WAIT_V(n) asm volatile("s_waitcnt vmcnt(" #n ")" ::: "memory")
#define PG8_WAIT_L(n) asm volatile("s_waitcnt lgkmcnt(" #n ")" ::: "memory")
#define PG8_BAR __builtin_amdgcn_s_barrier()
#define PG8_SCHED __builtin_amdgcn_sched_barrier(0)
#if GEMM_DBG
    unsigned long long gemm_dbg_epi = 0; const unsigned long long tg0_ = __builtin_amdgcn_s_memtime();
#endif
    Unit cur, nxt; int ui = 0;
    if (!S.next(0, cur)) return;
    cur.seq = 0; if constexpr (Epi::PREFETCH) E.prefetch(cur, wid, lane);
    f32x4 acc[2][2][4][2];
#pragma unroll
    for (int a = 0; a < 2; ++a)
#pragma unroll
        for (int b = 0; b < 2; ++b)
#pragma unroll
            for (int m = 0; m < 4; ++m)
#pragma unroll
                for (int n = 0; n < 2; ++n) acc[a][b][m][n] = (f32x4){0.f, 0.f, 0.f, 0.f};
    bf16x8 At[4][2], B0[2][2], B1[2][2];
    const char* cA = (const char*)g.A + (size_t)cur.pm * tstep; const char* cB = (const char*)g.Bt + (size_t)cur.pn * tstep;
    S.a_ready(cur);
    if constexpr (SP2) {
        PG8_STAGE(PG8_SB(0, 0), cB, voffB); PG8_STAGE(PG8_SB(0, 1), cB + hstep, voffB); PG8_STAGE(PG8_SA(0, 0), cA, voffA); PG8_STAGE(PG8_SA(0, 1), cA + hstep, voffA);
        if (wr == 1) PG8_BAR;
        PG8_WAIT_V(2); PG8_BAR;
        PG8_STAGE(PG8_SB(1, 0), cB + kstep, voffB); PG8_STAGE(PG8_SA(1, 0), cA + kstep, voffA); PG8_STAGE(PG8_SB(1, 1), cB + hstep + kstep, voffB);
        PG8_WAIT_V(6); PG8_BAR;
    } else {
        PG8_STAGE(PG8_SB(0, 0), cB, voffB); PG8_STAGE(PG8_SA(0, 0), cA, voffA); PG8_STAGE(PG8_SB(0, 1), cB + hstep, voffB); PG8_STAGE(PG8_SA(0, 1), cA + hstep, voffA);
        if (wr == 1) PG8_BAR;
        PG8_WAIT_V(4); PG8_BAR;
        PG8_STAGE(PG8_SB(1, 0), cB + kstep, voffB); PG8_STAGE(PG8_SA(1, 0), cA + kstep, voffA); PG8_STAGE(PG8_SB(1, 1), cB + hstep + kstep, voffB);
        PG8_WAIT_V(6); PG8_BAR;
    }
    for (;;) {
        const bool has_next = S.next(ui + 1, nxt); nxt.seq = ui + 1;
        const char* nA = has_next ? (const char*)g.A + (size_t)nxt.pm * tstep : cA; const char* nB = has_next ? (const char*)g.Bt + (size_t)nxt.pn * tstep : cB;
        for (int t = 0; t < nt; t += 2) {
            const bool last = (t == nt - 2);
            const char* a1 = cA + (size_t)(t + 1) * kstep;
            const char* a2 = last ? nA : cA + (size_t)(t + 2) * kstep; const char* b2 = last ? nB : cB + (size_t)(t + 2) * kstep;
            const char* a3 = a2 + kstep; const char* b3 = b2 + kstep;
            if (last && has_next) { S.a_ready(nxt); if constexpr (Epi::PREFETCH) E.prefetch(nxt, wid, lane); }
            if constexpr (SP2) {
            PG8_LDB(B0, 0, 0); PG8_LDB(B1, 0, 1); PG8_SCHED; PG8_LDA(At, 0, 0); PG8_STAGE(PG8_SA(1, 1), a1 + hstep, voffA);
            PG8_WAIT_V(8); PG8_WAIT_L(0); PG8_BAR; PG8_MMA(0, 0, At, B0); PG8_MMA(0, 1, At, B1); PG8_BAR; PG8_SCHED;
            PG8_LDA(At, 0, 1); PG8_STAGE(PG8_SB(0, 0), b2, voffB); PG8_STAGE(PG8_SB(0, 1), b2 + hstep, voffB); PG8_STAGE(PG8_SA(0, 0), a2, voffA);
            PG8_WAIT_V(8); PG8_WAIT_L(0); PG8_BAR; PG8_MMA(1, 0, At, B0); PG8_MMA(1, 1, At, B1); PG8_BAR; PG8_SCHED;
            PG8_LDB(B0, 1, 0); PG8_LDB(B1, 1, 1); PG8_SCHED; PG8_LDA(At, 1, 0); PG8_STAGE(PG8_SA(0, 1), a2 + hstep, voffA);
            PG8_WAIT_V(8); PG8_WAIT_L(0); PG8_BAR; PG8_MMA(0, 0, At, B0); PG8_MMA(0, 1, At, B1); PG8_BAR; PG8_SCHED;
            PG8_LDA(At, 1, 1); PG8_STAGE(PG8_SB(1, 0), b3, voffB); PG8_STAGE(PG8_SB(1, 1), b3 + hstep, voffB); PG8_STAGE(PG8_SA(1, 0), a3, voffA);
            PG8_WAIT_V(8); PG8_WAIT_L(0); PG8_BAR; PG8_MMA(1, 0, At, B0); PG8_MMA(1, 1, At, B1); PG8_BAR; PG8_SCHED;
            } else {
            PG8_LDB(B0, 0, 0); PG8_SCHED; PG8_LDA(At, 0, 0); PG8_STAGE(PG8_SA(1, 1), a1 + hstep, voffA);
            PG8_WAIT_L(8); PG8_BAR; PG8_WAIT_L(0); PG8_MMA(0, 0, At, B0); PG8_BAR; PG8_SCHED;
            PG8_LDB(B1, 0, 1); PG8_STAGE(PG8_SB(0, 0), b2, voffB);
            PG8_BAR; PG8_WAIT_L(0); PG8_MMA(0, 1, At, B1); PG8_BAR;
            PG8_LDA(At, 0, 1); PG8_STAGE(PG8_SA(0, 0), a2, voffA);
            PG8_BAR; PG8_WAIT_L(0); PG8_MMA(1, 0, At, B0); PG8_BAR; PG8_SCHED;
            PG8_STAGE(PG8_SB(0, 1), b2 + hstep, voffB);
            PG8_WAIT_V(6); PG8_BAR; PG8_MMA(1, 1, At, B1); PG8_BAR;
            PG8_LDB(B0, 1, 0); PG8_SCHED; PG8_LDA(At, 1, 0); PG8_STAGE(PG8_SA(0, 1), a2 + hstep, voffA);
            PG8_WAIT_L(8); PG8_BAR; PG8_WAIT_L(0); PG8_MMA(0, 0, At, B0); PG8_BAR; PG8_SCHED;
            PG8_LDB(B1, 1, 1); PG8_STAGE(PG8_SB(1, 0), b3, voffB);
            PG8_BAR; PG8_WAIT_L(0); PG8_MMA(0, 1, At, B1); PG8_BAR;
            PG8_LDA(At, 1, 1); PG8_STAGE(PG8_SA(1, 0), a3, voffA);
            PG8_BAR; PG8_WAIT_L(0); PG8_MMA(1, 0, At, B0); PG8_BAR; PG8_SCHED;
            PG8_STAGE(PG8_SB(1, 1), b3 + hstep, voffB);
            PG8_WAIT_V(6); PG8_BAR; PG8_MMA(1, 1, At, B1); PG8_BAR;
            }
        }
        if constexpr (ALIGN_EPI) { if (wr == 0) PG8_BAR; }
#if GEMM_DBG
        const unsigned long long te0_ = __builtin_amdgcn_s_memtime();
#endif
        if constexpr (!Epi::AFTER_DRAIN) { E(acc, cur, wr, wc, fr, fq); S.done(cur); }
#if GEMM_DBG
        asm volatile("s_waitcnt vmcnt(0)" ::: "memory"); gemm_dbg_epi += __builtin_amdgcn_s_memtime() - te0_;
#endif
        if (!has_next) break;
#pragma unroll
        for (int a = 0; a < 2; ++a)
#pragma unroll
            for (int b = 0; b < 2; ++b)
#pragma unroll
                for (int m = 0; m < 4; ++m)
#pragma unroll
                    for (int n = 0; n < 2; ++n) acc[a][b][m][n] = (f32x4){0.f, 0.f, 0.f, 0.f};
        cur = nxt; cA = nA; cB = nB; ++ui;
        if constexpr (ALIGN_EPI) { if (wr == 1) PG8_BAR; }
    }
#if GEMM_DBG
    if (g.dbg && blockIdx.x == 0 && tid == 0) { g.dbg[0] = __builtin_amdgcn_s_memtime() - tg0_; g.dbg[1] = gemm_dbg_epi; }
#endif
    PG8_WAIT_V(0);
    if constexpr (!ALIGN_EPI) { if (wr == 0) PG8_BAR; }
    PG8_BAR;
    if constexpr (Epi::AFTER_DRAIN) { E.fused(acc, cur, wr, wc, fr, fq, lds, wid, lane); S.done(cur); }
#undef PG8_SA
#undef PG8_SB
#undef PG8_STAGE
#undef PG8_LDA
#undef PG8_LDB
#undef PG8_MMA
#undef PG8_WAIT_V
#undef PG8_WAIT_L
#undef PG8_BAR
#undef PG8_SCHED
}
}
#ifndef PG8_SP2
#define PG8_SP2 true
#endif
#ifndef PG8_ALIGN
#define PG8_ALIGN true
#endif
namespace attn2 {
typedef unsigned short bf16;
typedef short bf16x8 __attribute__((ext_vector_type(8)));
typedef short s16x4 __attribute__((ext_vector_type(4)));
typedef float f32x16 __attribute__((ext_vector_type(16)));
typedef float f32x4 __attribute__((ext_vector_type(4)));
typedef unsigned u32x4 __attribute__((ext_vector_type(4)));
constexpr int NW = 8, QBLK = 32, KVBLK = 64, QB = NW * QBLK, DQ = 64, DV = 128, PQ = 7680, PO = 2048, SEQ = 4096, NQB = SEQ / QB;
constexpr int SHM_V = KVBLK * DV * 2, SHM_K = KVBLK * DQ * 2;
constexpr int LDS_WS = 2 * SHM_V + 2 * SHM_K, LDS_OST = LDS_WS + NW * 64 * 4, LDS_BYTES = LDS_OST + NW * QBLK * DV * 2;
constexpr float THR = 8.f;
#define A2_KSWZ(row, colB) ((row) * 128 + ((colB) ^ ((((row) >> 1) & 7) << 4)))
#define A2_SBAR() __builtin_amdgcn_sched_barrier(0)
__device__ __forceinline__ int v_st(int k, int c) { const int kk = k; return ((kk >> 3) * 4 + (c >> 5)) * 512 + ((kk & 7) * 32 + (c & 31)) * 2; }
__device__ __forceinline__ int v_rd_base(int lane) { return ((lane & 3) << 3) | (((lane >> 2) & 3) << 6) | (((lane >> 4) & 1) << 5) | (((lane >> 5) & 1) << 8); }
constexpr int v_rd_off(int d0, int ks, int half) { return d0 * 512 + ks * 4096 + half * 2048; }
__device__ __forceinline__ int crow(int r, int hi) { return (r & 3) + 8 * (r >> 2) + 4 * hi; }
__device__ __forceinline__ unsigned cvtpk(float lo, float hi) { unsigned r; asm volatile("v_cvt_pk_bf16_f32 %0, %1, %2" : "=v"(r) : "v"(lo), "v"(hi)); return r; }
__device__ __forceinline__ bf16x8 load8(const bf16* p) { return *reinterpret_cast<const bf16x8*>(p); }
__device__ __forceinline__ void mask_tile(f32x16& p0, f32x16& p1, int dq) {
    const float NEG = -__builtin_inff();
#pragma unroll
    for (int r = 0; r < 16; ++r) { const int c = (r & 3) + 8 * (r >> 2); if (dq - c < 0) p0[r] = NEG; if (dq - c - 32 < 0) p1[r] = NEG; }
}
__device__ __forceinline__ void softmax_tile(f32x16& p0, f32x16& p1, float& m_reg, f32x16& negm, f32x16 (&o)[4], float& l_reg, bool first, bf16x8& pa0, bf16x8& pa1, bf16x8& pa2, bf16x8& pa3) {
    float a = fmaxf(fmaxf(p0[0], p0[1]), p1[0]), b = fmaxf(fmaxf(p0[2], p0[3]), p1[1]);
#pragma unroll
    for (int r = 4; r < 16; r += 4) { a = fmaxf(fmaxf(a, p0[r]), p0[r + 1]); b = fmaxf(fmaxf(b, p0[r + 2]), p0[r + 3]); }
#pragma unroll
    for (int r = 2; r < 16; r += 2) { a = fmaxf(a, p1[r]); b = fmaxf(b, p1[r + 1]); }
    float pmax = fmaxf(a, b);
    if (__builtin_expect(first || !__all(pmax <= THR), 0)) {
        { auto rr = __builtin_amdgcn_permlane32_swap(__float_as_uint(pmax), __float_as_uint(pmax), false, false); pmax = fmaxf(__uint_as_float(rr[0]), __uint_as_float(rr[1])); }
        const float dl = first ? pmax : fmaxf(pmax, 0.f);
        m_reg += dl;
        if (!first) { const float alpha = __builtin_amdgcn_exp2f(-dl); l_reg *= alpha;
#pragma unroll
            for (int d_ = 0; d_ < 4; ++d_)
#pragma unroll
                for (int r = 0; r < 16; ++r) o[d_][r] *= alpha; }
#pragma unroll
        for (int r = 0; r < 16; ++r) { p0[r] -= dl; p1[r] -= dl; negm[r] -= dl; }
    }
#define A2_EXP(x) ({ float r_; asm volatile("v_exp_f32 %0, %1" : "=v"(r_) : "v"(x)); r_; })
#pragma unroll
    for (int r = 0; r < 16; ++r) p0[r] = A2_EXP(p0[r]);
#pragma unroll
    for (int r = 0; r < 16; ++r) p1[r] = A2_EXP(p1[r]);
#undef A2_EXP
#define A2_FADD(a, b) ({ float r_; asm volatile("v_add_f32 %0, %1, %2" : "=v"(r_) : "v"(a), "v"(b)); r_; })
    float s0 = A2_FADD(p0[0], p0[1]), s1 = A2_FADD(p0[2], p0[3]), s2 = A2_FADD(p1[0], p1[1]), s3 = A2_FADD(p1[2], p1[3]);
#pragma unroll
    for (int r = 4; r < 16; r += 4) { s0 = A2_FADD(s0, A2_FADD(p0[r], p0[r + 1])); s1 = A2_FADD(s1, A2_FADD(p0[r + 2], p0[r + 3])); s2 = A2_FADD(s2, A2_FADD(p1[r], p1[r + 1])); s3 = A2_FADD(s3, A2_FADD(p1[r + 2], p1[r + 3])); }
    const float ps = A2_FADD(A2_FADD(s0, s1), A2_FADD(s2, s3));
#undef A2_FADD
    l_reg += ps;
#define A2_PK4(P, B_, OUT) do { u32x4 w = {cvtpk(P[B_+0], P[B_+1]), cvtpk(P[B_+2], P[B_+3]), cvtpk(P[B_+4], P[B_+5]), cvtpk(P[B_+6], P[B_+7])}; OUT = *reinterpret_cast<bf16x8*>(&w); } while (0)
    A2_PK4(p0, 0, pa0); A2_PK4(p0, 8, pa1); A2_PK4(p1, 0, pa2); A2_PK4(p1, 8, pa3);
#undef A2_PK4
}
template <int KB> __device__ __forceinline__ void kload(bf16x8* kf, const char* K_lds, int r32, int hi) {
#pragma unroll
    for (int d0 = 0; d0 < 4; ++d0) { const char* a = K_lds + KB * SHM_K + A2_KSWZ(r32, (d0 * 16 + hi * 8) * 2);
        kf[2 * d0] = *reinterpret_cast<const bf16x8*>(a); kf[2 * d0 + 1] = *reinterpret_cast<const bf16x8*>(a + 32 * 128); }
}
__device__ __forceinline__ void qkt(f32x16& p0, f32x16& p1, const bf16x8* kf, const bf16x8* qr, const f32x16& negm) {
    p0 = negm; p1 = negm;
#pragma unroll
    for (int d0 = 0; d0 < 4; ++d0) { p0 = __builtin_amdgcn_mfma_f32_32x32x16_bf16(kf[2 * d0], qr[d0], p0, 0, 0, 0); p1 = __builtin_amdgcn_mfma_f32_32x32x16_bf16(kf[2 * d0 + 1], qr[d0], p1, 0, 0, 0); }
}
#define A2_TRRD(dst, off) asm volatile("ds_read_b64_tr_b16 %0, %1 offset:%2" : "=&v"(dst) : "v"(vb0), "i"(off) : "memory")
#define PV_RD0(VB) do { constexpr int b_ = (VB) * SHM_V + v_rd_off(0, 0, 0); A2_TRRD(al0, b_); A2_TRRD(ah0, b_ + 2048); A2_TRRD(al1, b_ + 4096); A2_TRRD(ah1, b_ + 6144); A2_TRRD(al2, b_ + 8192); A2_TRRD(ah2, b_ + 10240); A2_TRRD(al3, b_ + 12288); A2_TRRD(ah3, b_ + 14336); } while (0)
#define A2_PV_D0(VB, d0) do { s16x4 l0, l1, l2, l3, h0, h1, h2, h3; constexpr int b_ = (VB) * SHM_V + v_rd_off(d0, 0, 0); \
        A2_TRRD(l0, b_); A2_TRRD(h0, b_ + 2048); A2_TRRD(l1, b_ + 4096); A2_TRRD(h1, b_ + 6144); A2_TRRD(l2, b_ + 8192); A2_TRRD(h2, b_ + 10240); A2_TRRD(l3, b_ + 12288); A2_TRRD(h3, b_ + 14336); \
        asm volatile("s_waitcnt lgkmcnt(0)" ::: "memory"); A2_SBAR(); \
        o[d0] = __builtin_amdgcn_mfma_f32_32x32x16_bf16((bf16x8){l0[0], l0[1], l0[2], l0[3], h0[0], h0[1], h0[2], h0[3]}, pa0, o[d0], 0, 0, 0); \
        o[d0] = __builtin_amdgcn_mfma_f32_32x32x16_bf16((bf16x8){l1[0], l1[1], l1[2], l1[3], h1[0], h1[1], h1[2], h1[3]}, pa1, o[d0], 0, 0, 0); \
        o[d0] = __builtin_amdgcn_mfma_f32_32x32x16_bf16((bf16x8){l2[0], l2[1], l2[2], l2[3], h2[0], h2[1], h2[2], h2[3]}, pa2, o[d0], 0, 0, 0); \
        o[d0] = __builtin_amdgcn_mfma_f32_32x32x16_bf16((bf16x8){l3[0], l3[1], l3[2], l3[3], h3[0], h3[1], h3[2], h3[3]}, pa3, o[d0], 0, 0, 0); } while (0)
#define PV_REST(VB) do { asm volatile("s_waitcnt lgkmcnt(0)" ::: "memory"); A2_SBAR(); \
        o[0] = __builtin_amdgcn_mfma_f32_32x32x16_bf16((bf16x8){al0[0], al0[1], al0[2], al0[3], ah0[0], ah0[1], ah0[2], ah0[3]}, pa0, o[0], 0, 0, 0); \
        o[0] = __builtin_amdgcn_mfma_f32_32x32x16_bf16((bf16x8){al1[0], al1[1], al1[2], al1[3], ah1[0], ah1[1], ah1[2], ah1[3]}, pa1, o[0], 0, 0, 0); \
        o[0] = __builtin_amdgcn_mfma_f32_32x32x16_bf16((bf16x8){al2[0], al2[1], al2[2], al2[3], ah2[0], ah2[1], ah2[2], ah2[3]}, pa2, o[0], 0, 0, 0); \
        o[0] = __builtin_amdgcn_mfma_f32_32x32x16_bf16((bf16x8){al3[0], al3[1], al3[2], al3[3], ah3[0], ah3[1], ah3[2], ah3[3]}, pa3, o[0], 0, 0, 0); \
        A2_PV_D0(VB, 1); A2_PV_D0(VB, 2); A2_PV_D0(VB, 3); } while (0)
struct BlockRef { const bf16* Q; const bf16* K; const bf16* V; const bf16* G; bf16* Mx; int P0; int mapc; };
#define A2_VMW() asm volatile("s_waitcnt vmcnt(0)" ::: "memory")
#ifndef ATTN_DBG
#define ATTN_DBG 0
#endif
#ifndef ATTN_DBG_UNIT
#define ATTN_DBG_UNIT 0
#endif
#if ATTN_DBG
#define DBG_T() (dbg ? __builtin_amdgcn_s_memtime() : 0ull)
#define DBG_ACC(k, t0_) do { if (dbg) { const unsigned long long t1_ = __builtin_amdgcn_s_memtime(); dacc[k] += t1_ - (t0_); } } while (0)
#else
#define DBG_T() 0ull
#define DBG_ACC(k, t0_) do { } while (0)
#endif
__device__ __forceinline__ void unit_block(const BlockRef& cur, char* lds, float lam, const float* sw, float osc, int wv, unsigned long long* dbg) {
    int tid_ = wv * 64 + pg8::pg8_lane(); asm volatile("" : "+v"(tid_)); const int tid = tid_, wid = __builtin_amdgcn_readfirstlane(tid >> 6), lane = tid & 63, r32 = lane & 31, hi = lane >> 5;
    const bool grpB = wid >= 4;
#if ATTN_DBG
    unsigned long long dacc[6] = {0, 0, 0, 0, 0, 0}; const unsigned long long tu0 = DBG_T();
#endif
    const int NT = (cur.P0 + QB - 1) / KVBLK + 1;
    const int qlo = cur.P0 + wid * QBLK;
    char* V_lds = lds; char* K_lds = lds + 2 * SHM_V;
    float m_reg = 0.f, l_reg = 0; f32x16 o[4] = {}; f32x16 negm = {};
    const int sr = tid >> 4, sc = (tid & 15) * 8, vst0 = v_st(sr, sc), kr = tid >> 3, kc = (tid & 7) * 8, kws = A2_KSWZ(kr, kc * 2);
    const int vb0 = (int)(uintptr_t)V_lds + v_rd_base(lane);
    const unsigned koffB = (unsigned)(kr * PQ + kc) * 2u, voffB = (unsigned)(sr * PQ + sc) * 2u;
    const __amdgpu_buffer_rsrc_t rsK = __builtin_amdgcn_make_buffer_rsrc((void*)cur.K, (short)0, SEQ * PQ * 2, 0x00020000), rsV = __builtin_amdgcn_make_buffer_rsrc((void*)cur.V, (short)0, SEQ * PQ * 2, 0x00020000);
    bf16x8 qr[4], st_k, st_v0, st_v1;
#define A3_LDK(t) (st_k = __builtin_bit_cast(bf16x8, __builtin_amdgcn_raw_buffer_load_b128(rsK, koffB, (t) * (KVBLK * PQ * 2), 0)))
#define A3_LDV(t) do { st_v0 = __builtin_bit_cast(bf16x8, __builtin_amdgcn_raw_buffer_load_b128(rsV, voffB, (t) * (KVBLK * PQ * 2), 0)); st_v1 = __builtin_bit_cast(bf16x8, __builtin_amdgcn_raw_buffer_load_b128(rsV, voffB, (t) * (KVBLK * PQ * 2) + 32 * PQ * 2, 0)); } while (0)
#define A3_WRK(bf) (*(bf16x8*)(K_lds + (bf) * SHM_K + kws) = st_k)
#define A3_WRV(bf) do { *(bf16x8*)(V_lds + (bf) * SHM_V + vst0) = st_v0; *(bf16x8*)(V_lds + (bf) * SHM_V + vst0 + 8192) = st_v1;     } while (0)
#pragma unroll
    for (int d0 = 0; d0 < 4; ++d0) qr[d0] = load8(cur.Q + (size_t)(wid * QBLK + r32) * PQ + d0 * 16 + hi * 8);
    { A3_LDK(0); A3_LDV(0); const bf16x8 k1 = __builtin_bit_cast(bf16x8, __builtin_amdgcn_raw_buffer_load_b128(rsK, koffB, KVBLK * PQ * 2, 0)); A2_VMW(); A3_WRK(0); A3_WRV(0); *(bf16x8*)(K_lds + SHM_K + kws) = k1; }
    A3_LDK(2); A3_LDV(1);
    __syncthreads();
    f32x16 p0, p1; bf16x8 pa0, pa1, pa2, pa3;
#define A3_SOFTMAX(t) do { const unsigned long long tv_t = DBG_T(); const int kb_ = (t) * KVBLK; if (kb_ + KVBLK - 1 > qlo) mask_tile(p0, p1, qlo + r32 - 4 * hi - kb_); \
        softmax_tile(p0, p1, m_reg, negm, o, l_reg, (t) == 0, pa0, pa1, pa2, pa3); DBG_ACC(1, tv_t); } while (0)
#define A3_MFMA(t, KBN, VB) do { } while (0)
#define A3_STAGE(t, KBN, VB) do { const unsigned long long ts_ = DBG_T(); A2_VMW(); A3_WRK(VB); A3_WRV(KBN); A2_SBAR(); { const int tk_ = (t) + 3 < NT ? (t) + 3 : NT - 1, tv_ = (t) + 2 < NT ? (t) + 2 : NT - 1; A3_LDK(tk_); A3_LDV(tv_); } A2_SBAR(); DBG_ACC(2, ts_); } while (0)
#undef A3_MFMA
#define A3_MFMA(t, KBN, VB) do { const unsigned long long tm_ = DBG_T(); s16x4 al0, al1, al2, al3, ah0, ah1, ah2, ah3; PV_RD0(VB); { bf16x8 kf[8]; kload<KBN>(kf, K_lds, r32, hi); qkt(p0, p1, kf, qr, negm); } A2_SBAR(); PV_REST(VB); DBG_ACC(0, tm_); } while (0)
#define A3_BAR() do { const unsigned long long tb_ = DBG_T(); __syncthreads(); DBG_ACC(3, tb_); } while (0)
    if (!grpB) {
        { bf16x8 kf[8]; kload<0>(kf, K_lds, r32, hi); qkt(p0, p1, kf, qr, negm); } A3_BAR();
        A3_SOFTMAX(0); A3_BAR();
        for (int t = 0; t < NT; t += 2) {
            A3_STAGE(t, 1, 0); A3_MFMA(t, 1, 0); A3_BAR(); A3_SOFTMAX(t + 1); A3_BAR();
            A3_STAGE(t + 1, 0, 1); A3_MFMA(t + 1, 0, 1); A3_BAR(); if (t + 2 < NT) { A3_SOFTMAX(t + 2); } A3_BAR();
        }
    } else {
        A3_BAR();
        { bf16x8 kf[8]; kload<0>(kf, K_lds, r32, hi); qkt(p0, p1, kf, qr, negm); } A3_BAR();
        for (int t = 0; t < NT; t += 2) {
            A3_STAGE(t, 1, 0); A3_SOFTMAX(t); A3_BAR(); A3_MFMA(t, 1, 0); A3_BAR();
            A3_STAGE(t + 1, 0, 1); A3_SOFTMAX(t + 1); A3_BAR(); A3_MFMA(t + 1, 0, 1); A3_BAR();
        }
    }
    l_reg = pg8::add_xor32(l_reg);
    const float rl = __builtin_amdgcn_rcpf(l_reg);
    { bf16* stg = (bf16*)(lds + LDS_OST) + wid * (QBLK * DV); char* stb = (char*)stg; const int sbase = r32 * 256 + hi * 8, sx = r32 & 15;
      if (cur.mapc == 0) {
#pragma unroll
        for (int d0 = 0; d0 < 4; ++d0) {
#pragma unroll
          for (int g = 0; g < 4; ++g) { uint2 w; w.x = cvtpk(o[d0][4 * g] * rl, o[d0][4 * g + 1] * rl); w.y = cvtpk(o[d0][4 * g + 2] * rl, o[d0][4 * g + 3] * rl); *(uint2*)(stb + sbase + (((d0 * 4 + g) ^ sx) << 4)) = w; } }
      } else {
        u32x4 gv[8]; const bf16* Gw = cur.G + (size_t)(wid * QBLK) * PQ;
#pragma unroll
        for (int i = 0; i < 8; ++i) gv[i] = *(const u32x4*)(Gw + (size_t)(i * 4 + (lane >> 4)) * PQ + (lane & 15) * 8);
        float swv[8];
#pragma unroll
        for (int j = 0; j < 8; ++j) swv[j] = sw[(lane & 15) * 8 + j] * osc;
        const float nl = -lam * rl;
#pragma unroll
        for (int d0 = 0; d0 < 4; ++d0) {
#pragma unroll
          for (int g = 0; g < 4; ++g) { uint2* pp = (uint2*)(stb + sbase + (((d0 * 4 + g) ^ sx) << 4)); const uint2 v = *pp; uint2 w;
            w.x = cvtpk(__uint_as_float(v.x << 16) + nl * o[d0][4 * g], __uint_as_float(v.x & 0xffff0000u) + nl * o[d0][4 * g + 1]);
            w.y = cvtpk(__uint_as_float(v.y << 16) + nl * o[d0][4 * g + 2], __uint_as_float(v.y & 0xffff0000u) + nl * o[d0][4 * g + 3]); *pp = w; } }
        asm volatile("s_waitcnt lgkmcnt(0)" ::: "memory");
        bf16* Mw = cur.Mx + (size_t)(wid * QBLK) * PO;
#pragma unroll
        for (int i = 0; i < 8; ++i) { const int row = i * 4 + (lane >> 4), ch = lane & 15; const u32x4 v = *(const u32x4*)(stb + row * 256 + ((ch ^ (row & 15)) << 4));
          float d[8] = {__uint_as_float(v.x << 16), __uint_as_float(v.x & 0xffff0000u), __uint_as_float(v.y << 16), __uint_as_float(v.y & 0xffff0000u), __uint_as_float(v.z << 16), __uint_as_float(v.z & 0xffff0000u), __uint_as_float(v.w << 16), __uint_as_float(v.w & 0xffff0000u)};
          const u32x4 g = gv[i];
          const float gg[8] = {__uint_as_float(g.x << 16), __uint_as_float(g.x & 0xffff0000u), __uint_as_float(g.y << 16), __uint_as_float(g.y & 0xffff0000u), __uint_as_float(g.z << 16), __uint_as_float(g.z & 0xffff0000u), __uint_as_float(g.w << 16), __uint_as_float(g.w & 0xffff0000u)};
          float ss = 0.f;
#pragma unroll
          for (int j = 0; j < 8; ++j) ss += d[j] * d[j];
          ss += __int_as_float(__builtin_amdgcn_update_dpp(0, __float_as_int(ss), 0x128, 0xf, 0xf, false)); ss += __int_as_float(__builtin_amdgcn_update_dpp(0, __float_as_int(ss), 0x124, 0xf, 0xf, false));
          ss += __int_as_float(__builtin_amdgcn_update_dpp(0, __float_as_int(ss), 0x122, 0xf, 0xf, false)); ss += __int_as_float(__builtin_amdgcn_update_dpp(0, __float_as_int(ss), 0x121, 0xf, 0xf, false));
          const float rs = __builtin_amdgcn_rsqf(ss * (1.0f / 128.0f) + 1e-5f);
#pragma unroll
          for (int j = 0; j < 8; ++j) d[j] = d[j] * rs * swv[j] * gg[j];
          u32x4 w; w.x = cvtpk(d[0], d[1]); w.y = cvtpk(d[2], d[3]); w.z = cvtpk(d[4], d[5]); w.w = cvtpk(d[6], d[7]);
          *(u32x4*)(Mw + (size_t)row * PO + ch * 8) = w; }
      } }
#if ATTN_DBG
    if (dbg && lane == 0 && (wid == 0 || wid == 4)) { dacc[4] = __builtin_amdgcn_s_memtime() - tu0; for (int k = 0; k < 6; ++k) dbg[(wid >> 2) * 8 + k] = dacc[k]; }
#endif
    __syncthreads();
#undef A3_LDK
#undef A3_LDV
#undef A3_WRK
#undef A3_WRV
#undef A3_SOFTMAX
#undef A3_MFMA
#undef A3_STAGE
#undef A3_BAR
}
#undef A2_VMW
struct AttnTensors { const bf16* P; bf16* Mx; };
__device__ __forceinline__ BlockRef unit_ref(const AttnTensors& T, int vcu, int i) {
    const int s = vcu & 7, bh = vcu >> 3, b = bh >> 3, h = bh & 7, c = i & 1, qb = (i & 2) ? s : (NQB - 1 - s);
    BlockRef r; const size_t row0 = (size_t)b * SEQ, rowq = row0 + (size_t)qb * QB;
    r.Q = T.P + rowq * PQ + h * 128 + c * 64; r.K = T.P + row0 * PQ + 1024 + h * 128 + c * 64; r.V = T.P + row0 * PQ + 2048 + h * 128;
    r.G = T.P + rowq * PQ + 3072 + h * 128; r.Mx = T.Mx + rowq * PO + h * 128; r.P0 = qb * QB; r.mapc = c; return r;
}
__device__ __forceinline__ void attn_phase(char* lds, const AttnTensors& T, int vcu, float lam, const float* sw, float osc, int wv, unsigned long long* dbg) {
    if (vcu >= 256) return;
    for (int i = 0; i < 4; ++i) { const BlockRef cur = unit_ref(T, vcu, i); unit_block(cur, lds, lam, sw, osc, wv, (i == ATTN_DBG_UNIT && vcu == 0) ? dbg : nullptr); }
}
#undef A2_TRRD
#undef PV_RD0
#undef A2_PV_D0
#undef PV_REST
#undef A2_SBAR
#undef A2_KSWZ
}

constexpr int NWAVES = 8;
#ifndef ATTN_V2
#define ATTN_V2 1
#endif
#ifndef TAIL_COPIES
#define TAIL_COPIES 1
#endif
#ifndef FUSE_FINAL
#define FUSE_FINAL 1
#endif
#ifndef POLL_SLEEP
#define POLL_SLEEP 1
#endif
#ifndef MK_PER_PHASE
#define MK_PER_PHASE 0
#endif
constexpr int NPHASE = 8;

constexpr int BATCH = 4, SEQ = 4096, D = 2048, DEPTH = 2, NPROJ = 7680, NHEAD = 8;
constexpr int M = BATCH * SEQ;
constexpr float NORM_EPS = 1e-5f, LN_EPS = 1e-5f;
constexpr int PC_Q = 0, PC_K = 1024, PC_V = 2048, PC_GA = 3072, PC_U = 4096, PC_VS = 4608, PC_GB = 5120, PC_XC = 5632, PC_BG = 6144, PC_CG = 6656, PC_GC = 7168;

constexpr size_t MiB = 1u << 20;
constexpr size_t WS_CTL = 0, CTL_ZERO_BYTES = 1 * MiB;
constexpr size_t WS_SSQ1 = 256 * 1024;
constexpr size_t WS_DBG = 1 * MiB + 512 * 1024;
constexpr size_t WS_SSQ2 = 320 * 1024;
constexpr int CW_PANEL = 8192;
constexpr size_t WS_LNS = 384 * 1024;
constexpr size_t WS_SSQ0 = 1 * MiB;
constexpr size_t WS_TRIL = 3 * MiB;
constexpr size_t WS_WIN = 4 * MiB;
constexpr size_t WS_WOUT = 64 * MiB;
constexpr size_t WS_XB = 80 * MiB;
constexpr size_t WS_MIX = 144 * MiB;
constexpr size_t WS_PROJ = 208 * MiB;
constexpr size_t WS_END = 448 * MiB;
static_assert(WS_WIN + (size_t)DEPTH * NPROJ * D * 2 <= WS_WOUT && WS_WOUT + (size_t)DEPTH * D * D * 2 <= WS_XB && WS_XB + (size_t)M * D * 2 <= WS_MIX && WS_MIX + (size_t)M * D * 2 <= WS_PROJ && WS_PROJ + (size_t)M * NPROJ * 2 <= WS_END, "d_ws map");
constexpr int CW_BAR = 4096;

constexpr int RING_OFF = 0, RING_BYTES = 131072;
constexpr int LDSCTL_OFF = RING_BYTES, MISC_OFF = LDSCTL_OFF + 320;
constexpr int LDS_BYTES = 147456;
static_assert(MISC_OFF + 128 <= LDS_BYTES, "LDS map");

#define GAS __attribute__((address_space(1)))
#define LAS __attribute__((address_space(3)))
typedef unsigned short bf16;
typedef unsigned v4u __attribute__((ext_vector_type(4)));
typedef unsigned v2u __attribute__((ext_vector_type(2)));
typedef float f32x4 __attribute__((ext_vector_type(4)));
typedef short bf16x8 __attribute__((ext_vector_type(8)));
typedef GAS unsigned gu32;
#define RLX_AGENT __ATOMIC_RELAXED, __HIP_MEMORY_SCOPE_AGENT
#define LDS_WAIT() asm volatile("s_waitcnt lgkmcnt(0)" ::: "memory")
#define VM_WAIT() asm volatile("s_waitcnt vmcnt(0)" ::: "memory")
__device__ __forceinline__ unsigned f2bf(float f) { unsigned u = __builtin_bit_cast(unsigned, f); return (u + 0x7fffu + ((u >> 16) & 1u)) >> 16; }
__device__ __forceinline__ unsigned pk2(float lo, float hi) { return f2bf(lo) | (f2bf(hi) << 16); }
__device__ __forceinline__ float bflo(unsigned w) { return __uint_as_float(w << 16); }
__device__ __forceinline__ float bfhi(unsigned w) { return __uint_as_float(w & 0xffff0000u); }
__device__ __forceinline__ float bf1(bf16 b) { return __uint_as_float((unsigned)b << 16); }

#define XB_TMO      128
#define XB_XCNT(j)  (256  + 64 * (j))
#define XB_XSUB(j)  (1280 + 64 * (j))
#define XB_XGEN(j)  (2304 + 64 * (j))
#define XB_TOP      3328
#define XB_TOPGEN   3392
#define XCD_BAR_WORDS 3456
#define XB_SPIN_CAP (1u << 18)

__device__ __forceinline__ unsigned xb_ld(unsigned* p)              { return __hip_atomic_load(p, __ATOMIC_RELAXED, __HIP_MEMORY_SCOPE_AGENT); }
__device__ __forceinline__ unsigned xb_add(unsigned* p, unsigned v) { return __hip_atomic_fetch_add(p, v, __ATOMIC_RELAXED, __HIP_MEMORY_SCOPE_AGENT); }
__device__ __forceinline__ unsigned xb_xcc_id() { return (unsigned)__builtin_amdgcn_s_getreg((3 << 11) | 20) & 0xFu; }
#define XB_SPIN(cond, bar) do { unsigned _sp = 0; while (cond) { __builtin_amdgcn_s_sleep(POLL_SLEEP); \
    if ((++_sp & 255u) == 0u) { if (xb_ld(&(bar)[XB_TMO])) break; if (_sp > XB_SPIN_CAP) { atomicAdd(&(bar)[XB_TMO], 1u); break; } } } } while (0)

struct XcdBarrier {
    unsigned wv; unsigned* bar; unsigned x;
    volatile LAS unsigned* st;
};

__device__ __forceinline__ XcdBarrier xcd_barrier_post(unsigned* bar, volatile LAS unsigned* st) {
    XcdBarrier b; b.bar = bar; b.x = xb_xcc_id(); b.st = st;
    if (threadIdx.x == 0) (void)xb_add(&bar[XB_XCNT(b.x)], 1u);
    return b;
}
__device__ __forceinline__ void xcd_barrier_complete(unsigned* bar, unsigned x, unsigned& nloc, unsigned& nx) {
    const unsigned G = gridDim.x * gridDim.y * gridDim.z;
    unsigned sum, cnt, mine, sp = 0u;
    for (;;) {
        sum = 0u; cnt = 0u; mine = 0u;
#pragma unroll
        for (unsigned j = 0; j < 16; ++j) { const unsigned c = xb_ld(&bar[XB_XCNT(j)]); sum += c; cnt += (c > 0u) ? 1u : 0u; mine = (j == x) ? c : mine; }
        if (sum == G) break;
        __builtin_amdgcn_s_sleep(1);
        if ((++sp & 255u) == 0u) { if (xb_ld(&bar[XB_TMO])) break; if (sp > XB_SPIN_CAP) { atomicAdd(&bar[XB_TMO], 1u); break; } }
    }
    nloc = mine > 0u ? mine : 1u; nx = cnt > 0u ? cnt : 1u;
}

__device__ __forceinline__ void xcd_barrier(const XcdBarrier& b) {
    asm volatile("s_waitcnt vmcnt(0)" ::: "memory");
    __syncthreads();
    if (b.wv == 0u && pg8::pg8_lane() == 0) {
        unsigned* bar = b.bar;
        __builtin_amdgcn_s_waitcnt(0);
        unsigned nloc = b.st[0], nx = b.st[1];
        if (nloc == 0u) { xcd_barrier_complete(bar, b.x, nloc, nx); b.st[0] = nloc; b.st[1] = nx; }
        const unsigned old = xb_add(&bar[XB_XSUB(b.x)], 1u);
        const unsigned gen = old / nloc;
        if (old + 1u == (gen + 1u) * nloc) {
            __builtin_amdgcn_fence(__ATOMIC_RELEASE, "agent");
            asm volatile("s_waitcnt vmcnt(0)" ::: "memory");
            const unsigned og = xb_add(&bar[XB_TOP], 1u);
            const unsigned tg = og / nx;
            if (og + 1u == (tg + 1u) * nx) xb_add(&bar[XB_TOPGEN], 1u);
            else XB_SPIN(xb_ld(&bar[XB_TOPGEN]) == tg, bar);
            __builtin_amdgcn_fence(__ATOMIC_ACQUIRE, "agent");
            xb_add(&bar[XB_XGEN(b.x)], 1u);
            asm volatile("s_waitcnt vmcnt(0)" ::: "memory");
        } else {
            XB_SPIN(xb_ld(&bar[XB_XGEN(b.x)]) == gen, bar);
            __builtin_amdgcn_fence(__ATOMIC_ACQUIRE, "agent");
            asm volatile("s_waitcnt vmcnt(0)" ::: "memory");
        }
    }
    __syncthreads();
}

struct Frame {
    LAS unsigned char* lds;
    int tid, lane, wave;
    int vcu, G, wv;
};
__device__ __forceinline__ void frame_ids(Frame& F) {
    int t = F.wv * 64 + pg8::pg8_lane(); asm volatile("" : "+v"(t));
    F.tid = t; F.lane = t & 63; F.wave = __builtin_amdgcn_readfirstlane(t >> 6);
    int bx = blockIdx.x; asm volatile("" : "+s"(bx));
    F.G = gridDim.x; F.vcu = (F.G % 8 == 0) ? (bx % 8) * (F.G / 8) + bx / 8 : bx;
}

template <int CTRL> __device__ __forceinline__ float dpp_f(float v) { return __int_as_float(__builtin_amdgcn_update_dpp(0, __float_as_int(v), CTRL, 0xf, 0xf, false)); }
__device__ __forceinline__ float row16_sum(float v) { v += dpp_f<0x128>(v); v += dpp_f<0x124>(v); v += dpp_f<0x122>(v); v += dpp_f<0x121>(v); return v; }
__device__ __forceinline__ float wave_sum(float v) {
    v = row16_sum(v);
    const int vi = __float_as_int(v);
    const float a = __int_as_float(__builtin_amdgcn_readlane(vi, 0)), b = __int_as_float(__builtin_amdgcn_readlane(vi, 16)), c = __int_as_float(__builtin_amdgcn_readlane(vi, 32)), d = __int_as_float(__builtin_amdgcn_readlane(vi, 48));
    return (a + b) + (c + d);
}
__device__ __forceinline__ int pair_dest_row(int pair, int ch, int isB) {
    const int tile = (pair == 0) ? ((ch >> 7) < 2 ? 16 + (ch >> 7) : 18 + (ch >> 7)) : (pair == 1) ? ((ch >> 7) < 2 ? 22 + (ch >> 7) : 24 + (ch >> 7)) : ((ch >> 7) < 2 ? 24 + (ch >> 7) : 26 + (ch >> 7));
    return tile * 256 + 128 * isB + (ch & 127);
}
__device__ __forceinline__ int qk_dest_row(int n) {
    if (n >= 4096) {
        if (n < 4608) return pair_dest_row(0, n - 4096, 0);
        if (n < 5120) return n;
        if (n < 5632) return pair_dest_row(0, n - 5120, 1);
        if (n < 6144) return pair_dest_row(1, n - 5632, 0);
        if (n < 6656) return pair_dest_row(2, n - 6144, 0);
        if (n < 7168) return pair_dest_row(1, n - 6656, 1);
        return pair_dest_row(2, n - 7168, 1);
    }
    if (n >= 2048) return n; const int v = n >> 6, d = n & 63; const int j = (d < 32) ? ((d >> 2) * 8 + (d & 3)) : (((d - 32) >> 2) * 8 + 4 + (d & 3)); return (v << 6) + j; }
__device__ __forceinline__ void p0_transpose_item(const float* W, int K, int N, bf16* WT, const float* kscale, bool perm, int item, int lane) {
    const int nblk = N / 64, kb = item / nblk, nb = item % nblk, k0 = 64 * kb, n = 64 * nb + lane;
    const GAS float* src = (const GAS float*)W + (size_t)k0 * N + n;
    float v[64];
#pragma unroll
    for (int i = 0; i < 64; ++i) v[i] = src[(size_t)i * N];
    if (kscale) {
#pragma unroll
        for (int i = 0; i < 64; ++i) v[i] *= kscale[k0 + i];
    }
    const int nd = perm ? qk_dest_row(n) : n;
    GAS v4u* dst = (GAS v4u*)(WT + (size_t)nd * K + k0);
#pragma unroll
    for (int j = 0; j < 8; ++j) { v4u o; o.x = pk2(v[8 * j], v[8 * j + 1]); o.y = pk2(v[8 * j + 2], v[8 * j + 3]); o.z = pk2(v[8 * j + 4], v[8 * j + 5]); o.w = pk2(v[8 * j + 6], v[8 * j + 7]); dst[j] = o; }
}
struct Args { const float* in[15]; float* out; unsigned char* ws; int ph_lo, ph_hi; };
typedef const __attribute__((address_space(4))) Args* KArgs;
__device__ __forceinline__ KArgs kargs() { KArgs p = (KArgs)__builtin_amdgcn_kernarg_segment_ptr(); asm volatile("" : "+s"(p)); return p; }
enum { I_X = 0, I_NORMW, I_WIN, I_LQ1, I_LK1, I_LQ2, I_LK2, I_SUBLN, I_LNG, I_LNB, I_WS, I_BS, I_CONVW, I_WOUT, I_FINALW };
constexpr int I_IN = (D / 64) * (NPROJ / 64), I_OUT = (D / 64) * (D / 64), I_LAYER = I_IN + I_OUT;
__device__ __forceinline__ void weight_items(Frame& F, int lo, int hi, int w, int nw) {
    KArgs ka = kargs(); unsigned char* const ws = ka->ws;
    bf16* win = (bf16*)(ws + WS_WIN); bf16* wout = (bf16*)(ws + WS_WOUT);
    const float* w_in = ka->in[I_WIN]; const float* w_out = ka->in[I_WOUT]; const float* norm_w = ka->in[I_NORMW];
    for (int it = lo + w; it < hi; it += nw) {
        int r = it; const int l = r / I_LAYER; r -= l * I_LAYER;
        if (r < I_IN) p0_transpose_item(w_in + (size_t)l * D * NPROJ, D, NPROJ, win + (size_t)l * NPROJ * D, norm_w + l * D, true, r, F.lane);
        else p0_transpose_item(w_out + (size_t)l * D * D, D, D, wout + (size_t)l * D * D, nullptr, false, r - I_IN, F.lane);
    }
}
__device__ __forceinline__ void p0_prologue(Frame& F) {
    KArgs ka = kargs(); unsigned char* const ws = ka->ws;
    const int gw = F.vcu * NWAVES + F.wave, NGW = F.G * NWAVES;
    weight_items(F, 0, TAIL_COPIES ? I_IN : DEPTH * I_LAYER, gw, NGW);
    bf16* xb = (bf16*)(ws + WS_XB); float* ssq0 = (float*)(ws + WS_SSQ0); const float* x = ka->in[I_X];
    for (int m0 = gw * 2; m0 < M; m0 += NGW * 2) {
        f32x4 v[2][8];
#pragma unroll
        for (int i = 0; i < 2; ++i)
#pragma unroll
            for (int j = 0; j < 8; ++j) v[i][j] = ((const GAS f32x4*)(x + (size_t)(m0 + i) * D))[64 * j + F.lane];
#pragma unroll
        for (int i = 0; i < 2; ++i) { float s = 0.f;
            GAS unsigned long long* o8 = (GAS unsigned long long*)(xb + (size_t)(m0 + i) * D) + F.lane;
#pragma unroll
            for (int j = 0; j < 8; ++j) { s += (v[i][j].x * v[i][j].x + v[i][j].y * v[i][j].y) + (v[i][j].z * v[i][j].z + v[i][j].w * v[i][j].w);
                o8[64 * j] = (unsigned long long)pk2(v[i][j].x, v[i][j].y) | ((unsigned long long)pk2(v[i][j].z, v[i][j].w) << 32); }
            s = wave_sum(s);
            if (F.lane == 0) ssq0[m0 + i] = s; }
    }
    const int gt = F.vcu * (NWAVES * 64) + F.tid, NGT = F.G * NWAVES * 64;
    bf16* tril = (bf16*)(ws + WS_TRIL); const float* w_s = ka->in[I_WS];
    for (int e = gt; e < DEPTH * 4 * 128 * 128; e += NGT) { const int s = e & 127, t = (e >> 7) & 127; tril[e] = (s <= t) ? (bf16)f2bf(w_s[e]) : (bf16)0; }
}

__device__ __forceinline__ void unpack8(const v4u w, float (&f)[8]) { f[0] = bflo(w.x); f[1] = bfhi(w.x); f[2] = bflo(w.y); f[3] = bfhi(w.y); f[4] = bflo(w.z); f[5] = bfhi(w.z); f[6] = bflo(w.w); f[7] = bfhi(w.w); }
__device__ __forceinline__ v4u pack8(const float (&f)[8]) { v4u w; w.x = pk2(f[0], f[1]); w.y = pk2(f[2], f[3]); w.z = pk2(f[4], f[5]); w.w = pk2(f[6], f[7]); return w; }
__device__ __forceinline__ void sgu_item(Frame& F, unsigned char* ws, const float* ln_g, const float* ln_b, const float* b_s, const float* lns, int layer, int item) {
    const int chunk = item >> 2, g = item & 3, row0 = chunk * 128, lane = F.lane, wave = F.wave;
    const bf16* proj = (const bf16*)(ws + WS_PROJ); bf16* mix = (bf16*)(ws + WS_MIX);
    LAS bf16* vnT = (LAS bf16*)(F.lds + RING_OFF);
    const int tl0 = 16 * wave, t = tl0 + (lane & 15), row = row0 + t;
    bf16 e0[16], e1[16];
#pragma unroll
    for (int tt = 0; tt < 16; ++tt) { const bf16* rp = proj + (size_t)(row0 + tl0 + tt) * NPROJ + PC_VS + g * 128; e0[tt] = rp[lane]; e1[tt] = rp[64 + lane]; }
    const float st1 = lns[2 * (size_t)row], st2 = lns[2 * (size_t)row + 1];
    const float g0 = ln_g[layer * 512 + g * 128 + lane], g1 = ln_g[layer * 512 + g * 128 + 64 + lane], b0 = ln_b[layer * 512 + g * 128 + lane], b1 = ln_b[layer * 512 + g * 128 + 64 + lane];
    const bf16* tril = (const bf16*)(ws + WS_TRIL) + (size_t)(layer * 4 + g) * 128 * 128;
    bf16x8 b[4]; v2u u2[8];
#pragma unroll
    for (int ks = 0; ks < 4; ++ks) b[ks] = *(const GAS bf16x8*)(tril + t * 128 + 32 * ks + 8 * (lane >> 4));
    const float bs = b_s[(layer * 4 + g) * 128 + t];
#pragma unroll
    for (int dt = 0; dt < 8; ++dt) { const int ch4 = g * 128 + 16 * dt + 4 * (lane >> 4); u2[dt] = *(const GAS v2u*)(proj + (size_t)row * NPROJ + PC_U + ch4); }
    const float mean_l = st1 * (1.0f / 512.0f), rstd_l = __builtin_amdgcn_rsqf(fmaxf(st2 * (1.0f / 512.0f) - mean_l * mean_l, 0.f) + LN_EPS);
#pragma unroll
    for (int tt = 0; tt < 16; ++tt) {
        const float mean = __int_as_float(__builtin_amdgcn_readlane(__float_as_int(mean_l), tt)), rstd = __int_as_float(__builtin_amdgcn_readlane(__float_as_int(rstd_l), tt));
        vnT[lane * 136 + tl0 + tt] = (bf16)f2bf((bf1(e0[tt]) - mean) * rstd * g0 + b0);
        vnT[(64 + lane) * 136 + tl0 + tt] = (bf16)f2bf((bf1(e1[tt]) - mean) * rstd * g1 + b1);
    }
    LDS_WAIT(); __syncthreads();
#pragma unroll
    for (int dt = 0; dt < 8; ++dt) {
        f32x4 acc = (f32x4){0.f, 0.f, 0.f, 0.f};
#pragma unroll
        for (int ks = 0; ks < 4; ++ks) { const bf16x8 a = *(const LAS bf16x8*)(vnT + (16 * dt + (lane & 15)) * 136 + 32 * ks + 8 * (lane >> 4)); acc = __builtin_amdgcn_mfma_f32_16x16x32_bf16(a, b[ks], acc, 0, 0, 0); }
        const int ch4 = g * 128 + 16 * dt + 4 * (lane >> 4);
        v2u o; o.x = pk2(bflo(u2[dt].x) * (acc[0] + bs), bfhi(u2[dt].x) * (acc[1] + bs)); o.y = pk2(bflo(u2[dt].y) * (acc[2] + bs), bfhi(u2[dt].y) * (acc[3] + bs));
        *(GAS v2u*)(mix + (size_t)row * D + 1024 + ch4) = o;
    }
    LDS_WAIT(); __syncthreads();
}
__device__ __forceinline__ float lam_of(KArgs ka, int layer, int lane) {
    const float a = wave_sum(ka->in[I_LQ1][layer * 64 + lane] * ka->in[I_LK1][layer * 64 + lane]), b = wave_sum(ka->in[I_LQ2][layer * 64 + lane] * ka->in[I_LK2][layer * 64 + lane]);
    const float lam_init = 0.8f - 0.6f * __expf(-0.3f * (float)layer);
    return __expf(a) - __expf(b) + lam_init;
}
__device__ __forceinline__ void mix_phase(Frame& F, int layer) {
    KArgs ka = kargs(); unsigned char* const ws = ka->ws;
    { const float* ln_g = ka->in[I_LNG]; const float* ln_b = ka->in[I_LNB]; const float* b_s = ka->in[I_BS];
      const float* lns = (const float*)(ws + WS_LNS) + (size_t)layer * M * 2;
      for (int it = F.vcu; it < 512; it += F.G) sgu_item(F, ws, ln_g, ln_b, b_s, lns, layer, it); }
    const bf16* proj = (const bf16*)(ws + WS_PROJ); bf16* mix = (bf16*)(ws + WS_MIX); const bf16* atto = (const bf16*)ka->out;
    const float* subln_w = ka->in[I_SUBLN]; const float* conv_w = ka->in[I_CONVW];
    const int lane = F.lane, gw = F.vcu * NWAVES + F.wave, NGW = F.G * NWAVES;
    const float lam_init = 0.8f - 0.6f * __expf(-0.3f * (float)layer), lam = lam_of(ka, layer, lane);
    for (int blk = gw; blk < M / 8; blk += NGW) {
        const int r0 = blk * 8;
        { float cw0[8], cw1[8], cw2[8];
#pragma unroll
          for (int j = 0; j < 8; ++j) { cw0[j] = conv_w[(layer * 3 + 0) * 512 + 8 * lane + j]; cw1[j] = conv_w[(layer * 3 + 1) * 512 + 8 * lane + j]; cw2[j] = conv_w[(layer * 3 + 2) * 512 + 8 * lane + j]; }
          v4u rx[2][6], rbg[2][4];
#pragma unroll
          for (int hb = 0; hb < 2; ++hb) { const int rb = r0 + 4 * hb; const bool halo = (rb & (SEQ - 1)) != 0;
#pragma unroll
            for (int i = 0; i < 6; ++i) { const int row = (halo || i >= 2) ? rb - 2 + i : rb; const bf16* rp = proj + (size_t)row * NPROJ + 8 * lane; rx[hb][i] = *(const GAS v4u*)(rp + PC_XC); }
#pragma unroll
            for (int i = 0; i < 4; ++i) { const bf16* rp = proj + (size_t)(rb + i) * NPROJ + 8 * lane; rbg[hb][i] = *(const GAS v4u*)(rp + PC_BG); } }
#pragma unroll
          for (int hb = 0; hb < 2; ++hb) { const int rb = r0 + 4 * hb; const bool halo = (rb & (SEQ - 1)) != 0;
            float z[6][8];
#pragma unroll
            for (int i = 0; i < 6; ++i) { float a[8]; unpack8(rx[hb][i], a);
#pragma unroll
                for (int j = 0; j < 8; ++j) z[i][j] = (halo || i >= 2) ? a[j] : 0.f; }
#pragma unroll
            for (int i = 0; i < 4; ++i) { float bg[8], y[8]; unpack8(rbg[hb][i], bg);
#pragma unroll
                for (int j = 0; j < 8; ++j) y[j] = bg[j] * (cw0[j] * z[i][j] + cw1[j] * z[i + 1][j] + cw2[j] * z[i + 2][j]);
                *(GAS v4u*)(mix + (size_t)(rb + i) * D + 1536 + 8 * lane) = pack8(y); }
          } }
    }
}
__device__ __forceinline__ void final_norm(Frame& F) {
    KArgs ka = kargs(); float* const out = ka->out; const float* final_w = ka->in[I_FINALW]; const bf16* xb = (const bf16*)(ka->ws + WS_XB);
    const int gw = F.vcu * NWAVES + F.wave, NGW = F.G * NWAVES;
    for (int m0 = gw * 4; m0 < M; m0 += NGW * 4) {
        v4u raw[4][4];
#pragma unroll
        for (int i = 0; i < 4; ++i)
#pragma unroll
            for (int j = 0; j < 4; ++j) raw[i][j] = ((const GAS v4u*)(xb + (size_t)(m0 + i) * D))[64 * j + F.lane];
#pragma unroll
        for (int i = 0; i < 4; ++i) { float v[4][8]; float s = 0.f;
#pragma unroll
            for (int j = 0; j < 4; ++j) { unpack8(raw[i][j], v[j]);
#pragma unroll
                for (int e = 0; e < 8; ++e) s += v[j][e] * v[j][e]; }
            const float rs = __builtin_amdgcn_rsqf(wave_sum(s) * (1.0f / 2048.0f) + NORM_EPS);
            GAS f32x4* orow = (GAS f32x4*)(out + (size_t)(m0 + i) * D);
#if ATTN_DBG || GEMM_DBG
            const float dbgv = (m0 + i == 0 && F.lane == 0) ? (float)((const unsigned long long*)(ka->ws + WS_DBG))[ATTN_DBG_SEL] * ATTN_DBG_SCALE : 0.f;
#endif
#pragma unroll
            for (int j = 0; j < 4; ++j) { const f32x4 w0 = ((const GAS f32x4*)final_w)[128 * j + 2 * F.lane], w1 = ((const GAS f32x4*)final_w)[128 * j + 2 * F.lane + 1];
#if ATTN_DBG || GEMM_DBG
                if (j == 0 && dbgv != 0.f) v[0][0] = dbgv / (rs * w0.x);
#endif
                orow[128 * j + 2 * F.lane] = (f32x4){v[j][0] * rs * w0.x, v[j][1] * rs * w0.y, v[j][2] * rs * w0.z, v[j][3] * rs * w0.w};
                orow[128 * j + 2 * F.lane + 1] = (f32x4){v[j][4] * rs * w1.x, v[j][5] * rs * w1.y, v[j][6] * rs * w1.z, v[j][7] * rs * w1.w}; }
        }
    }
}

__global__ void __launch_bounds__(NWAVES * 64, 2) hybrid_fwd(Args args) {
    extern __shared__ __attribute__((aligned(16))) unsigned char lds[];
    Frame F;
    F.lds = (LAS unsigned char*)lds;
    F.wv = __builtin_amdgcn_readfirstlane((int)threadIdx.x >> 6);
    volatile LAS unsigned* MISC = (volatile LAS unsigned*)(F.lds + MISC_OFF);
    for (int u = threadIdx.x; u < (LDS_BYTES - LDSCTL_OFF) / 4; u += NWAVES * 64) ((LAS unsigned*)(F.lds + LDSCTL_OFF))[u] = 0u;
    __syncthreads();
    XcdBarrier bar; bar.bar = (unsigned*)(args.ws + WS_CTL) + CW_BAR; bar.x = 0; bar.st = nullptr;
    if (!MK_PER_PHASE) bar = xcd_barrier_post((unsigned*)(args.ws + WS_CTL) + CW_BAR, MISC + 8);
    bar.wv = (unsigned)F.wv;
    const int lo = args.ph_lo, hi = args.ph_hi;
#ifndef PH_MASK
#define PH_MASK 0x3f
#endif
#define IN(k) (lo <= (k) && (k) < hi)
#define EN(b) ((PH_MASK >> (b)) & 1)
#ifndef REP_MASK
#define REP_MASK 0
#endif
#define NREP(b) (((REP_MASK >> (b)) & 1) + 1)
#define SEAM(k) do { if (IN(k) && IN((k) + 1)) xcd_barrier(bar); } while (0)

    if (EN(0) && IN(0)) { for (int rep = 0; rep < NREP(0); ++rep) { if (rep) xcd_barrier(bar); frame_ids(F); p0_prologue(F); } } SEAM(0);
    for (int layer = 0; layer < DEPTH; ++layer) {
        const int pb = 1 + 3 * layer;
        if (EN(1) && IN(pb)) for (int rep = 0; rep < NREP(1); ++rep) {
            if (rep) xcd_barrier(bar);
            unsigned char* const ws = kargs()->ws;
            pg8::Gemm g{(const pg8::bf16_t*)(ws + WS_XB), (const pg8::bf16_t*)(ws + WS_WIN) + (size_t)layer * NPROJ * D, M, NPROJ, D, (GEMM_DBG == 1 && layer == 0) ? (unsigned long long*)(ws + WS_DBG) : nullptr};
            pg8::StaticOrder S; S.init(M, NPROJ, (int)gridDim.x, (int)blockIdx.x); S.wv = F.wv;
            pg8::EpiProj E{(pg8::bf16_t*)(ws + WS_PROJ), (const float*)(ws + (layer == 0 ? WS_SSQ0 : WS_SSQ1)), (float*)(ws + WS_LNS) + (size_t)layer * M * 2, (LAS float*)(F.lds + LDSCTL_OFF + 1024)};
            pg8::gemm_phase<pg8::EpiProj, pg8::StaticOrder, PG8_ALIGN, PG8_SP2>(F.lds + RING_OFF, g, S, E);
            if (TAIL_COPIES && rep == 0) {
                const int G_ = (int)gridDim.x, nwg = (M / 256) * (NPROJ / 256), full = nwg % G_;
                if (full != 0 && (int)blockIdx.x >= full) { frame_ids(F); const int w = ((int)blockIdx.x - full) * NWAVES + F.wave, nw = (G_ - full) * NWAVES;
                    if (layer == 0) weight_items(F, I_IN, I_LAYER + I_IN, w, nw); else weight_items(F, I_LAYER + I_IN, 2 * I_LAYER, w, nw); }
                else if (full == 0 && layer == 0) { frame_ids(F); weight_items(F, I_IN, 2 * I_LAYER, F.vcu * NWAVES + F.wave, F.G * NWAVES); }
            }
        }
        SEAM(pb);
        if (IN(pb + 1)) for (int rep = 0; rep < NREP(2) + NREP(3) - 1; ++rep) {
            if (rep) xcd_barrier(bar);
            frame_ids(F); const bool mix_first = ((F.vcu >> 3) & 1) == 0;
            for (int st = 0; st < 2; ++st) {
                if ((st == 0) == mix_first) { if (EN(3) && (rep == 0 || NREP(3) == 2)) { frame_ids(F); mix_phase(F, layer); } }
                else if (EN(2) && (rep == 0 || NREP(2) == 2)) {
                    KArgs ka = kargs(); unsigned char* const ws = ka->ws; frame_ids(F);
                    const float lam_init = 0.8f - 0.6f * __expf(-0.3f * (float)layer), lam = lam_of(ka, layer, F.lane);
                    const attn2::AttnTensors AT{(const attn2::bf16*)(ws + WS_PROJ), (attn2::bf16*)(ws + WS_MIX)};
                    attn2::attn_phase((char*)lds + RING_OFF, AT, F.vcu, lam, ka->in[I_SUBLN] + layer * 128, 1.0f - lam_init, F.wv, (ATTN_DBG && layer == 0) ? (unsigned long long*)(ws + WS_DBG) : nullptr);
                }
            }
        }
        SEAM(pb + 1);
        if (EN(4) && IN(pb + 2)) for (int rep = 0; rep < (layer == 0 ? NREP(4) : 1); ++rep) {
            if (rep) xcd_barrier(bar);
            KArgs ka = kargs(); unsigned char* const ws = ka->ws; const float* xin = ka->in[I_X];
            pg8::Gemm g{(const pg8::bf16_t*)(ws + WS_MIX), (const pg8::bf16_t*)(ws + WS_WOUT) + (size_t)layer * D * D, M, D, D, (GEMM_DBG == 2 && layer == 0) ? (unsigned long long*)(ws + WS_DBG) : nullptr};
            if (FUSE_FINAL && layer == DEPTH - 1) {
                frame_ids(F); pg8::PanelOrder S{F.vcu, F.G, F.wv};
                pg8::EpiFinal E{(const pg8::bf16_t*)(ws + WS_XB), ka->out, ka->in[I_FINALW], (float*)(ws + WS_SSQ2), (unsigned*)(ws + WS_CTL) + CW_PANEL};
                pg8::gemm_phase<pg8::EpiFinal, pg8::PanelOrder, PG8_ALIGN, PG8_SP2>(F.lds + RING_OFF, g, S, E);
            } else {
            pg8::StaticOrder S; S.init(M, D, (int)gridDim.x, (int)blockIdx.x); S.wv = F.wv;
            pg8::EpiResid E{nullptr, (const pg8::bf16_t*)(ws + WS_XB), (pg8::bf16_t*)(ws + WS_XB), (layer == 0 && rep == 0) ? (float*)(ws + WS_SSQ1) : nullptr};
            pg8::gemm_phase<pg8::EpiResid, pg8::StaticOrder, PG8_ALIGN, PG8_SP2>(F.lds + RING_OFF, g, S, E);
            }
        }
        if (!(FUSE_FINAL && layer == DEPTH - 1)) SEAM(pb + 2);
    }
    if (!FUSE_FINAL && EN(5) && IN(7)) { frame_ids(F); final_norm(F); }
#undef IN
#undef SEAM
}

extern "C" void kernel_launch(void* const* d_in, const int* in_sizes, int n_in, void* d_out, int out_size, void* d_ws, size_t ws_size, hipStream_t stream) {
    static int grid = 0;
    if (grid == 0) {
        if (n_in != 15 || in_sizes[0] != M * D || out_size != M * D || ws_size < WS_END) { fprintf(stderr, "kernel_launch: shape/workspace mismatch (n_in %d, in0 %d, out %d, ws %zu); nothing launched\n", n_in, n_in > 0 ? in_sizes[0] : -1, out_size, ws_size); grid = -1; return; }
        int dev = 0, cus = 0, per_cu = 0;
        if (hipGetDevice(&dev) != hipSuccess || hipDeviceGetAttribute(&cus, hipDeviceAttributeMultiprocessorCount, dev) != hipSuccess) { grid = -1; return; }
        if (hipFuncSetAttribute((const void*)hybrid_fwd, hipFuncAttributeMaxDynamicSharedMemorySize, LDS_BYTES) != hipSuccess) { fprintf(stderr, "kernel_launch: hipFuncSetAttribute failed\n"); grid = -1; return; }
        if (hipOccupancyMaxActiveBlocksPerMultiprocessor(&per_cu, (const void*)hybrid_fwd, NWAVES * 64, LDS_BYTES) != hipSuccess || per_cu < 1)
            fprintf(stderr, "kernel_launch: note: occupancy query reports %d workgroups per CU\n", per_cu);
        (void)hipGetLastError();
        grid = cus;
    }
    if (grid < 0) return;
    if (hipMemsetAsync((char*)d_ws + WS_CTL, 0, CTL_ZERO_BYTES, stream) != hipSuccess) { fprintf(stderr, "kernel_launch: hipMemsetAsync failed\n"); return; }
    Args a{};
    for (int i = 0; i < 15; ++i) a.in[i] = (const float*)d_in[i];
    a.out = (float*)d_out; a.ws = (unsigned char*)d_ws;
#if MK_PER_PHASE
    for (int p = 0; p < NPHASE; ++p) { a.ph_lo = p; a.ph_hi = p + 1; hipLaunchKernelGGL(hybrid_fwd, dim3(grid), dim3(NWAVES * 64), LDS_BYTES, stream, a); }
#else
    a.ph_lo = 0; a.ph_hi = NPHASE;
    hipLaunchKernelGGL(hybrid_fwd, dim3(grid), dim3(NWAVES * 64), LDS_BYTES, stream, a);
#endif
    const hipError_t le = hipPeekAtLastError();
    if (le != hipSuccess) fprintf(stderr, "kernel_launch: launch failed: %s\n", hipGetErrorName(le));
}
```
